# Optimizing an MI355X kernel written in HIP

```python
import jax, jax.numpy as jnp
from jax import lax
import numpy as np

D_MODEL = 1024
BATCH = 16
SEQ = 256
DEPTH = 2
DEC_BATCH = 2
DEC_SEQ = 1024
PAST_LEN = 256

GRID_W = 64
N_EVEN = (DEPTH + 1) // 2
N_ODD = DEPTH // 2
RMS_EPS = 1e-6
D_CONV = D_MODEL // 2
CONV_W = 3
D_RWKV = D_MODEL // 2
RWKV_HEAD = 64
RWKV_HEADS = D_RWKV // RWKV_HEAD
N_DIR = 2
LORA_W = 64
LORA_A = 64
LORA_G = 128
DECAY_SCALE = 0.606531
GN_EPS = 64e-5
RWKV_COLS = 3 * D_RWKV + N_DIR * LORA_W + N_DIR * LORA_A + LORA_G
IN0_COLS = 3 * D_CONV + RWKV_COLS
MLA_HEADS = 8
Q_LORA = 384
KV_LORA = 256
NOPE = 128
ROPE = 64
ROPE_AXIS = ROPE // 2
V_DIM = 128
IN1_COLS = Q_LORA + KV_LORA + ROPE
ROPE_THETA = 10000.0
ATTN_SCALE = (NOPE + ROPE) ** -0.5
Q_BLOCK = 128
N_EXPERTS = 16
EXPERT_FF = 1024
CAP_FACTOR = 2

kernel_name = 'hybrid_diffusion_conv_rwkv7_mla_ecmoe_step'


def rms_norm(x, g):
    xf = x.astype(jnp.float32)
    y = xf * lax.rsqrt(jnp.mean(xf * xf, axis=-1, keepdims=True) + RMS_EPS)
    return (y * g.astype(jnp.float32)).astype(x.dtype)


def ada_modulation(cvec, w, b):
    m = jax.nn.silu(cvec) @ w + b
    return m.reshape(cvec.shape[0], 6, D_MODEL)


def modulate(x, g, shift, scale):
    return rms_norm(x, g) * (1 + scale[:, None, :]) + shift[:, None, :]


def pad_seq(u):
    return jnp.pad(u, ((0, 0), (1, 1), (0, 0)))


def centred_conv3(u, w):
    up = pad_seq(u)
    return w[0] * up[:, :-2] + w[1] * up[:, 1:-1] + w[2] * up[:, 2:]


def centred_shift(u):
    up = pad_seq(u)
    return 0.5 * (up[:, :-2] + up[:, 2:])


def to_heads(t):
    return t.reshape(t.shape[:-1] + (RWKV_HEADS, RWKV_HEAD))


def rwkv_scan(r, w, k, v, kk, a, s0, reverse):
    xs = tuple(jnp.moveaxis(t, 1, 0) for t in (r, w, k, v, kk, a))

    def step(S, inp):
        r_t, w_t, k_t, v_t, kk_t, a_t = inp
        sa = jnp.einsum('bhvk,bhk->bhv', S, -kk_t)
        S = (S * w_t[:, :, None, :]
             + sa[..., None] * (kk_t * a_t)[:, :, None, :]
             + v_t[..., None] * k_t[:, :, None, :])
        return S, jnp.einsum('bhvk,bhk->bhv', S, r_t)

    s_final, ys = lax.scan(step, s0, xs, reverse=reverse)
    return jnp.moveaxis(ys, 0, 1), s_final


def even_mixer(h, s0, w_in, conv_w, mu, w0, w2, a0, a2, g2, k_k, k_a, r_k, ln_w, ln_b, w_out):
    B, T, _ = h.shape
    z = h @ w_in
    za, zb = z[..., :3 * D_CONV], z[..., 3 * D_CONV:]
    gate_b, gate_c, xa = jnp.split(za, 3, axis=-1)
    y_conv = gate_b * centred_conv3(gate_c * xa, conv_w)
    zb = zb.astype(jnp.float32)
    zb = zb + mu * (centred_shift(zb) - zb)
    r, k, v, lw, la, lg = jnp.split(
        zb, [D_RWKV, 2 * D_RWKV, 3 * D_RWKV, 3 * D_RWKV + N_DIR * LORA_W,
             3 * D_RWKV + N_DIR * (LORA_W + LORA_A)], axis=-1)
    lw = lw.reshape(B, T, N_DIR, LORA_W)
    la = la.reshape(B, T, N_DIR, LORA_A)
    w = jnp.exp(-DECAY_SCALE * jax.nn.sigmoid(w0 + jnp.einsum('btnl,nlc->btnc', jnp.tanh(lw), w2)))
    a = jax.nn.sigmoid(a0 + jnp.einsum('btnl,nlc->btnc', la, a2))
    g = jax.nn.sigmoid(lg) @ g2
    kk = to_heads(k * k_k)
    kk = kk * lax.rsqrt(jnp.maximum(jnp.sum(kk * kk, axis=-1, keepdims=True), 1e-12))
    k_dir = k[:, :, None, :] * (1 + (a - 1) * k_a)
    rh, vh = to_heads(r), to_heads(v)
    y = jnp.zeros_like(rh)
    finals = []
    for d in range(N_DIR):
        y_d, s_d = rwkv_scan(rh, to_heads(w[:, :, d]), to_heads(k_dir[:, :, d]), vh, kk,
                             to_heads(a[:, :, d]), s0[:, d].astype(jnp.float32), reverse=(d == 1))
        y = y + y_d
        finals.append(s_d)
    mean = jnp.mean(y, axis=-1, keepdims=True)
    var = jnp.mean(jnp.square(y - mean), axis=-1, keepdims=True)
    y = ((y - mean) * lax.rsqrt(var + GN_EPS)).reshape(B, T, D_RWKV) * ln_w + ln_b
    bonus = jnp.sum(to_heads(r * k * r_k), axis=-1, keepdims=True) * vh
    y_rwkv = (y + bonus.reshape(B, T, D_RWKV)) * g
    out = jnp.concatenate([y_conv, y_rwkv.astype(h.dtype)], axis=-1) @ w_out
    return out, jnp.stack(finals, axis=1)


def axial_rope_tables(n_tokens):
    rows = n_tokens // GRID_W
    row = jnp.repeat(jnp.arange(rows, dtype=jnp.float32), GRID_W)
    col = jnp.tile(jnp.arange(GRID_W, dtype=jnp.float32), rows)
    inv_freq = ROPE_THETA ** (-jnp.arange(0, ROPE_AXIS, 2, dtype=jnp.float32) / ROPE_AXIS)
    ang_r = row[:, None, None] * inv_freq
    ang_c = col[:, None, None] * inv_freq
    return (jnp.cos(ang_r), jnp.sin(ang_r), jnp.cos(ang_c), jnp.sin(ang_c))


def rope_half(x, cos, sin):
    x1, x2 = jnp.split(x, 2, axis=-1)
    return jnp.concatenate([x1 * cos - x2 * sin, x1 * sin + x2 * cos], axis=-1)


def rope2d(x, tab):
    cos_r, sin_r, cos_c, sin_c = tab
    xr, xc = jnp.split(x.astype(jnp.float32), 2, axis=-1)
    return jnp.concatenate([rope_half(xr, cos_r, sin_r), rope_half(xc, cos_c, sin_c)], axis=-1).astype(x.dtype)


def mla_project(h, w_in, q_norm, kv_norm, w_qb):
    B, T, _ = h.shape
    z = h @ w_in
    cq, ckv, kpe = jnp.split(z, [Q_LORA, Q_LORA + KV_LORA], axis=-1)
    q = (rms_norm(cq, q_norm) @ w_qb).reshape(B, T, MLA_HEADS, NOPE + ROPE)
    return q[..., :NOPE], q[..., NOPE:], rms_norm(ckv, kv_norm), kpe


def mla_expand(ckv, w_kvb):
    B, T, _ = ckv.shape
    kv = (ckv @ w_kvb).reshape(B, T, MLA_HEADS, NOPE + V_DIM)
    return kv[..., :NOPE], kv[..., NOPE:]


def mla_attend(q_nope, q_pe, k_nope, k_pe, v):
    B, Tq = q_nope.shape[:2]
    nb = Tq // Q_BLOCK

    def blocks(t):
        return jnp.moveaxis(t.reshape((B, nb, Q_BLOCK) + t.shape[2:]), 1, 0)

    def one_block(qs):
        qn, qp = qs
        s = jnp.einsum('bqhd,bkhd->bhqk', qn, k_nope) + jnp.einsum('bqhr,bkr->bhqk', qp, k_pe)
        p = jax.nn.softmax(s.astype(jnp.float32) * ATTN_SCALE, axis=-1)
        return jnp.einsum('bhqk,bkhd->bqhd', p.astype(v.dtype), v)

    o = lax.map(one_block, (blocks(q_nope), blocks(q_pe)))
    return jnp.moveaxis(o, 0, 1).reshape(B, Tq, MLA_HEADS * V_DIM)


def mla_context(h, w_in, q_norm, kv_norm, w_qb, w_kvb, w_out):
    q_nope, q_pe, ckv, kpe = mla_project(h, w_in, q_norm, kv_norm, w_qb)
    k_nope, v = mla_expand(ckv, w_kvb)
    o = mla_attend(q_nope, q_pe, k_nope, kpe, v)
    return o @ w_out, ckv, kpe


def mla_latent(h, ckv_ctx, kpe_ctx, tab, w_in, q_norm, kv_norm, w_qb, w_kvb, w_out):
    q_nope, q_pe, ckv, kpe = mla_project(h, w_in, q_norm, kv_norm, w_qb)
    q_pe = rope2d(q_pe, tab)
    kpe = rope2d(kpe[:, :, None, :], tab)[:, :, 0]
    k_nope, v = mla_expand(ckv, w_kvb)
    k_nope_c, v_c = mla_expand(ckv_ctx, w_kvb)
    o = mla_attend(q_nope, q_pe,
                   jnp.concatenate([k_nope_c, k_nope], axis=1),
                   jnp.concatenate([kpe_ctx.astype(kpe.dtype), kpe], axis=1),
                   jnp.concatenate([v_c, v], axis=1))
    return o @ w_out


def ec_moe(h, router_w, w1, w3, w2):
    B, T, D = h.shape
    n = B * T
    cap = CAP_FACTOR * n // N_EXPERTS
    xf = h.reshape(n, D)
    aff = jax.nn.softmax((xf @ router_w).astype(jnp.float32), axis=-1)
    gate, idx = lax.top_k(aff.T, cap)
    xe = xf[idx]
    hid = jax.nn.silu(jnp.einsum('ecd,edf->ecf', xe, w1)) * jnp.einsum('ecd,edf->ecf', xe, w3)
    ye = jnp.einsum('ecf,efd->ecd', hid, w2) * gate[..., None].astype(xe.dtype)
    out = jnp.zeros((n, D), ye.dtype).at[idx.reshape(-1)].add(ye.reshape(-1, D))
    return out.reshape(B, T, D).astype(h.dtype)


def setup_inputs(seed: int = 0) -> dict:
    key = jax.random.key(seed)
    ks = iter(jax.random.split(key, 64))

    def nrm(shape, scale):
        return scale * jax.random.normal(next(ks), shape, jnp.float32)

    H, N = RWKV_HEADS, RWKV_HEAD
    return {
        'x_prompt': nrm((BATCH, SEQ, D_MODEL), 1.0),
        'x_sample': nrm((DEC_BATCH, DEC_SEQ, D_MODEL), 1.0),
        'state_rwkv': nrm((DEC_BATCH, N_EVEN, N_DIR, H, N, N), 0.1),
        'cache_mla_ckv': nrm((DEC_BATCH, N_ODD, PAST_LEN, KV_LORA), 1.0),
        'cache_mla_kpe': nrm((DEC_BATCH, N_ODD, PAST_LEN, ROPE), 1.0),
        'c': nrm((DEC_BATCH, D_MODEL), 1.0),
        'c_ctx': nrm((D_MODEL,), 1.0),
        'w_ada': nrm((DEPTH, D_MODEL, 6 * D_MODEL), 0.2 * D_MODEL ** -0.5),
        'b_ada': nrm((DEPTH, 6 * D_MODEL), 0.01),
        'norm_mix': 1.0 + nrm((DEPTH, D_MODEL), 0.05),
        'norm_ffn': 1.0 + nrm((DEPTH, D_MODEL), 0.05),
        'w_in0': nrm((N_EVEN, D_MODEL, IN0_COLS), D_MODEL ** -0.5),
        'conv_w0': nrm((N_EVEN, CONV_W, D_CONV), CONV_W ** -0.5),
        'rwkv_mu': jax.random.uniform(next(ks), (N_EVEN, RWKV_COLS), jnp.float32),
        'rwkv_w0': nrm((N_EVEN, N_DIR, D_RWKV), 0.5),
        'rwkv_w2': nrm((N_EVEN, N_DIR, LORA_W, D_RWKV), 0.5 * LORA_W ** -0.5),
        'rwkv_a0': nrm((N_EVEN, N_DIR, D_RWKV), 0.1),
        'rwkv_a2': nrm((N_EVEN, N_DIR, LORA_A, D_RWKV), LORA_A ** -0.5),
        'rwkv_g2': nrm((N_EVEN, LORA_G, D_RWKV), LORA_G ** -0.5),
        'rwkv_k_k': 0.85 + nrm((N_EVEN, D_RWKV), 0.05),
        'rwkv_k_a': 1.0 + nrm((N_EVEN, D_RWKV), 0.05),
        'rwkv_r_k': nrm((N_EVEN, D_RWKV), 0.1),
        'rwkv_ln_w': 1.0 + nrm((N_EVEN, D_RWKV), 0.05),
        'rwkv_ln_b': nrm((N_EVEN, D_RWKV), 0.01),
        'w_out0': nrm((N_EVEN, D_CONV + D_RWKV, D_MODEL), (D_CONV + D_RWKV) ** -0.5),
        'w_in1': nrm((N_ODD, D_MODEL, IN1_COLS), D_MODEL ** -0.5),
        'mla_q_norm': 1.0 + nrm((N_ODD, Q_LORA), 0.05),
        'mla_kv_norm': 1.0 + nrm((N_ODD, KV_LORA), 0.05),
        'w_qb': nrm((N_ODD, Q_LORA, MLA_HEADS * (NOPE + ROPE)), Q_LORA ** -0.5),
        'w_kvb': nrm((N_ODD, KV_LORA, MLA_HEADS * (NOPE + V_DIM)), KV_LORA ** -0.5),
        'w_out1': nrm((N_ODD, MLA_HEADS * V_DIM, D_MODEL), (MLA_HEADS * V_DIM) ** -0.5),
        'router_w': nrm((DEPTH, D_MODEL, N_EXPERTS), D_MODEL ** -0.5),
        'w_e1': nrm((DEPTH, N_EXPERTS, D_MODEL, EXPERT_FF), D_MODEL ** -0.5),
        'w_e3': nrm((DEPTH, N_EXPERTS, D_MODEL, EXPERT_FF), D_MODEL ** -0.5),
        'w_e2': nrm((DEPTH, N_EXPERTS, EXPERT_FF, D_MODEL), EXPERT_FF ** -0.5),
        'norm_final': 1.0 + nrm((D_MODEL,), 0.05),
    }


def reference(x_prompt, x_sample, state_rwkv, cache_mla_ckv, cache_mla_kpe, c, c_ctx,
              w_ada, b_ada, norm_mix, norm_ffn,
              w_in0, conv_w0, rwkv_mu, rwkv_w0, rwkv_w2, rwkv_a0, rwkv_a2, rwkv_g2,
              rwkv_k_k, rwkv_k_a, rwkv_r_k, rwkv_ln_w, rwkv_ln_b, w_out0,
              w_in1, mla_q_norm, mla_kv_norm, w_qb, w_kvb, w_out1,
              router_w, w_e1, w_e3, w_e2, norm_final):
    xp, xs = x_prompt, x_sample
    tab = axial_rope_tables(x_sample.shape[1])
    s0_ctx = jnp.zeros((xp.shape[0], N_DIR, RWKV_HEADS, RWKV_HEAD, RWKV_HEAD), jnp.float32)
    new_states, new_ckv, new_kpe = [], [], []
    for i in range(DEPTH):
        j = i // 2
        m_p = ada_modulation(c_ctx[None, :], w_ada[i], b_ada[i])
        m_s = ada_modulation(c, w_ada[i], b_ada[i])
        h_p = modulate(xp, norm_mix[i], m_p[:, 0], m_p[:, 1])
        h_s = modulate(xs, norm_mix[i], m_s[:, 0], m_s[:, 1])
        if i % 2 == 0:
            ep = (w_in0[j], conv_w0[j], rwkv_mu[j], rwkv_w0[j], rwkv_w2[j], rwkv_a0[j], rwkv_a2[j],
                  rwkv_g2[j], rwkv_k_k[j], rwkv_k_a[j], rwkv_r_k[j], rwkv_ln_w[j], rwkv_ln_b[j], w_out0[j])
            o_p, st = even_mixer(h_p, s0_ctx, *ep)
            o_s, _ = even_mixer(h_s, state_rwkv[:, j], *ep)
            new_states.append(st)
        else:
            op = (w_in1[j], mla_q_norm[j], mla_kv_norm[j], w_qb[j], w_kvb[j], w_out1[j])
            o_p, ckv, kpe = mla_context(h_p, *op)
            o_s = mla_latent(h_s, cache_mla_ckv[:, j], cache_mla_kpe[:, j], tab, *op)
            new_ckv.append(ckv)
            new_kpe.append(kpe)
        xp = xp + m_p[:, 2][:, None, :] * o_p
        xs = xs + m_s[:, 2][:, None, :] * o_s
        h_p = modulate(xp, norm_ffn[i], m_p[:, 3], m_p[:, 4])
        h_s = modulate(xs, norm_ffn[i], m_s[:, 3], m_s[:, 4])
        xp = xp + m_p[:, 5][:, None, :] * ec_moe(h_p, router_w[i], w_e1[i], w_e3[i], w_e2[i])
        xs = xs + m_s[:, 5][:, None, :] * ec_moe(h_s, router_w[i], w_e1[i], w_e3[i], w_e2[i])
    y_prompt = rms_norm(xp, norm_final)
    y_sample = rms_norm(xs, norm_final)
    new_state_rwkv = jnp.stack(new_states, axis=1)
    new_cache_mla_ckv = jnp.stack(new_ckv, axis=1)
    new_cache_mla_kpe = jnp.stack(new_kpe, axis=1)
    return (y_prompt, y_sample, new_state_rwkv, new_cache_mla_ckv, new_cache_mla_kpe)
```

```cpp
#include <hip/hip_runtime.h>
#include <stdint.h>
#include <stdio.h>

typedef __attribute__((ext_vector_type(8))) short bf16x8;
typedef __attribute__((ext_vector_type(16))) float f32x16;
typedef unsigned short bf16_t;
typedef const __attribute__((address_space(4))) float cflt;
#define LAS __attribute__((address_space(3)))

#define NTOK 6144
#define NPR 4096
#define NSA 2048
#define DM 1024
#define IN0C 3456
#define ZMC 1920
#define IN1C 704
#define NKROW 6656
#define DECAY_SCALE 0.606531f
#define GN_EPS 64e-5f
#define RMS_EPS 1e-6f
#define ATTN_SCALE 0.07216878364870322f

#define WS_BAR   0ull
#define WS_MOD   (64ull << 10)
#define WS_ROPE  (WS_MOD + (256ull << 10))
#define WS_AFF   (WS_ROPE + (64ull << 10))
#define WS_IDX   (WS_AFF + (512ull << 10))
#define WS_GATE  (WS_IDX + (64ull << 10))
#define WS_H     (1ull << 20)
#define WS_YCAT  (WS_H + 12582912ull)
#define WS_XCUR  (WS_YCAT + 12582912ull)
#define WS_HID   (WS_XCUR + 25165824ull)
#define WS_Z     (WS_HID + 25165824ull)
#define WS_ZM    (WS_Z + 84934656ull)
#define WS_OPSA  (WS_ZM + 47185920ull)
#define WS_OPSB  (WS_OPSA + 25165824ull)
#define WS_GG    (WS_OPSB + 75497472ull)
#define WS_YD    (WS_GG + 12582912ull)
#define WS_UD    (WS_YD + 25165824ull)
#define WS_PQ    (WS_UD + 25165824ull)
#define WS_SEL   (WS_PQ + 25165824ull)
#define WS_END0  (WS_SEL + 393216ull)
#define WS_YE    WS_ZM
#define WS_Z1    WS_Z
#define WS_CQN   (WS_Z1 + 17301504ull)
#define WS_CKVN  (WS_CQN + 4718592ull)
#define WS_KPE   (WS_CKVN + 3407872ull)
#define WS_QBUF  (WS_KPE + 851968ull)
#define WS_KH    (WS_QBUF + 18874368ull)
#define WS_VT    (WS_KH + 20447232ull)

#define O_Y    0
#define O_ST   6291456
#define O_CKV  7340032
#define O_KPE  8388608

struct P {
  const float* in[36];
  float* out;
  unsigned char* ws;
  int ph_lo, ph_hi;
  int probe_ph, probe_reps;
};

struct C : P { int tid, bid, nb, vb; };

#define SMEM_BYTES 61440
__shared__ __attribute__((aligned(16))) unsigned char smem[SMEM_BYTES];
__shared__ uint4 xb_words;

__device__ __forceinline__ unsigned pk2(float lo, float hi) {
  typedef __attribute__((ext_vector_type(2))) __bf16 bf2;
  typedef __attribute__((ext_vector_type(2))) float fl2;
  fl2 f = {lo, hi};
  bf2 b = __builtin_convertvector(f, bf2);
  return __builtin_bit_cast(unsigned, b);
}
__device__ __forceinline__ bf16_t f2bf(float f) { return (bf16_t)(pk2(f, 0.f) & 0xffffu); }
__device__ __forceinline__ float bf2f(bf16_t b) { return __uint_as_float(((unsigned)b) << 16); }
__device__ __forceinline__ float sigmoidf_(float x) { return 1.f / (1.f + expf(-x)); }
template <int M> __device__ __forceinline__ float swz(float v) {
  return __builtin_bit_cast(float, __builtin_amdgcn_ds_swizzle(__builtin_bit_cast(int, v), (M << 10) | 0x1f));
}
__device__ __forceinline__ float shx32(float v, int lane) {
  return __builtin_bit_cast(float, __builtin_amdgcn_ds_bpermute((lane ^ 32) << 2, __builtin_bit_cast(int, v)));
}
__device__ __forceinline__ float wave_sum(float v, int lane) {
  v += swz<1>(v); v += swz<2>(v); v += swz<4>(v); v += swz<8>(v); v += swz<16>(v); v += shx32(v, lane);
  return v;
}
__device__ __forceinline__ float4 ldg4(const float* base, unsigned off) { return *(const float4*)((const char*)base + (size_t)(off * 4u)); }
__device__ __forceinline__ int modrow(int tok) { return tok < NPR ? 0 : 1 + ((tok - NPR) >> 10); }

#define XB_TMO      128
#define XB_XCNT(j)  (256  + 64 * (j))
#define XB_XSUB(j)  (1280 + 64 * (j))
#define XB_XGEN(j)  (2304 + 64 * (j))
#define XB_TOP      3328
#define XB_TOPGEN   3392
#define XCD_BAR_WORDS 3456
#define XB_SPIN_CAP (1u << 20)
__device__ __forceinline__ unsigned xb_ld(unsigned* p)              { return __hip_atomic_load(p, __ATOMIC_RELAXED, __HIP_MEMORY_SCOPE_AGENT); }
__device__ __forceinline__ unsigned xb_add(unsigned* p, unsigned v) { return __hip_atomic_fetch_add(p, v, __ATOMIC_RELAXED, __HIP_MEMORY_SCOPE_AGENT); }
__device__ __forceinline__ unsigned xb_xcc_id() { return (unsigned)__builtin_amdgcn_s_getreg((3 << 11) | 20) & 0xFu; }
#define XB_SPIN(cond, bar) do { unsigned _sp = 0; while (cond) { __builtin_amdgcn_s_sleep(1); \
    if ((++_sp & 255u) == 0u) { if (xb_ld(&(bar)[XB_TMO])) break; if (_sp > XB_SPIN_CAP) { atomicAdd(&(bar)[XB_TMO], 1u); break; } } } } while (0)
struct XcdBarrier { unsigned* bar; unsigned x; volatile LAS unsigned* st; };
__device__ __forceinline__ XcdBarrier xcd_barrier_post(unsigned* bar, volatile LAS unsigned* st) {
  XcdBarrier b; b.bar = bar; b.x = xb_xcc_id(); b.st = st;
  if (threadIdx.x == 0) (void)xb_add(&bar[XB_XCNT(b.x)], 1u);
  return b;
}
__device__ __forceinline__ void xcd_barrier_complete(unsigned* bar, unsigned x, unsigned& nloc, unsigned& nx) {
  const unsigned G = gridDim.x * gridDim.y * gridDim.z;
  unsigned sum, cnt, mine, sp = 0u;
  for (;;) {
    sum = 0u; cnt = 0u; mine = 0u;
#pragma unroll
    for (unsigned j = 0; j < 16; ++j) { const unsigned c = xb_ld(&bar[XB_XCNT(j)]); sum += c; cnt += (c > 0u) ? 1u : 0u; mine = (j == x) ? c : mine; }
    if (sum == G) break;
    __builtin_amdgcn_s_sleep(1);
    if ((++sp & 255u) == 0u) { if (xb_ld(&bar[XB_TMO])) break; if (sp > XB_SPIN_CAP) { atomicAdd(&bar[XB_TMO], 1u); break; } }
  }
  nloc = mine > 0u ? mine : 1u; nx = cnt > 0u ? cnt : 1u;
}
__device__ __forceinline__ void xcd_barrier(const XcdBarrier& b) {
  asm volatile("s_waitcnt vmcnt(0)" ::: "memory");
  __syncthreads();
  if (threadIdx.x == 0) {
    unsigned* bar = b.bar;
    __builtin_amdgcn_s_waitcnt(0);
    unsigned nloc = b.st[0], nx = b.st[1];
    if (nloc == 0u) { xcd_barrier_complete(bar, b.x, nloc, nx); b.st[0] = nloc; b.st[1] = nx; }
    const unsigned old = xb_add(&bar[XB_XSUB(b.x)], 1u);
    const unsigned gen = old / nloc;
    if (old + 1u == (gen + 1u) * nloc) {
      __builtin_amdgcn_fence(__ATOMIC_RELEASE, "agent");
      asm volatile("s_waitcnt vmcnt(0)" ::: "memory");
      const unsigned og = xb_add(&bar[XB_TOP], 1u);
      const unsigned tg = og / nx;
      if (og + 1u == (tg + 1u) * nx) xb_add(&bar[XB_TOPGEN], 1u);
      else XB_SPIN(xb_ld(&bar[XB_TOPGEN]) == tg, bar);
      __builtin_amdgcn_fence(__ATOMIC_ACQUIRE, "agent");
      xb_add(&bar[XB_XGEN(b.x)], 1u);
      asm volatile("s_waitcnt vmcnt(0)" ::: "memory");
    } else {
      XB_SPIN(xb_ld(&bar[XB_XGEN(b.x)]) == gen, bar);
      __builtin_amdgcn_fence(__ATOMIC_ACQUIRE, "agent");
      asm volatile("s_waitcnt vmcnt(0)" ::: "memory");
    }
  }
  __syncthreads();
}

#define LDS_S 72
template <int NB, bool PAIR, class AL, class BL, class EP>
__device__ __forceinline__ void gemm_core(int tid_, int K, AL al, BL bl, EP ep) {
  bf16_t* As = (bf16_t*)smem;
  bf16_t* Bs = As + 128 * LDS_S;
  const int tid = tid_, lane = tid & 63, wave = tid >> 6;
  const int wm = wave >> 1, wn = wave & 1, l31 = lane & 31, lh = lane >> 5;
  f32x16 acc[NB][2][2];
#pragma unroll
  for (int b = 0; b < NB; ++b)
#pragma unroll
    for (int i = 0; i < 2; ++i)
#pragma unroll
      for (int j = 0; j < 2; ++j)
#pragma unroll
        for (int r = 0; r < 16; ++r) acc[b][i][j][r] = 0.f;
  const int arow = tid >> 1, akb = (tid & 1) * 32;
  const int bng = (tid & 31) * 4, bkg = (tid >> 5) * 8;
  uint4 ra[4]; float4 rb[2][8];
#pragma unroll
  for (int i = 0; i < 4; ++i) ra[i] = al(arow, akb + i * 8);
#pragma unroll
  for (int i = 0; i < 8; ++i) rb[0][i] = bl(0, bkg + i, bng);
  if (K > 64) {
#pragma unroll
    for (int i = 0; i < 8; ++i) rb[1][i] = bl(0, 64 + bkg + i, bng);
  }
#pragma unroll 1
  for (int kbase = 0; kbase < K; kbase += 128) {
#pragma unroll
  for (int hb = 0; hb < 2; ++hb) {
    const int k0 = kbase + hb * 64;
    if (k0 < K) {
#pragma unroll
    for (int i = 0; i < 4; ++i) *(uint4*)&As[arow * LDS_S + akb + i * 8] = ra[i];
#pragma unroll
    for (int j = 0; j < 4; ++j) {
      uint4 w;
      w.x = pk2(((const float*)&rb[hb][0])[j], ((const float*)&rb[hb][1])[j]);
      w.y = pk2(((const float*)&rb[hb][2])[j], ((const float*)&rb[hb][3])[j]);
      w.z = pk2(((const float*)&rb[hb][4])[j], ((const float*)&rb[hb][5])[j]);
      w.w = pk2(((const float*)&rb[hb][6])[j], ((const float*)&rb[hb][7])[j]);
      *(uint4*)&Bs[(bng + j) * LDS_S + bkg] = w;
    }
    __syncthreads();
    if (k0 + 64 < K) {
#pragma unroll
      for (int i = 0; i < 4; ++i) ra[i] = al(arow, k0 + 64 + akb + i * 8);
    }
    if (k0 + 128 < K) {
#pragma unroll
      for (int i = 0; i < 8; ++i) rb[hb][i] = bl(0, k0 + 128 + bkg + i, bng);
    }
#pragma unroll
    for (int ks = 0; ks < 4; ++ks) {
      bf16x8 af[2], bfr[2];
#pragma unroll
      for (int mt = 0; mt < 2; ++mt) af[mt] = *(const bf16x8*)&As[(wm * 64 + mt * 32 + l31) * LDS_S + ks * 16 + lh * 8];
#pragma unroll
      for (int nt = 0; nt < 2; ++nt) bfr[nt] = *(const bf16x8*)&Bs[(wn * 64 + nt * 32 + l31) * LDS_S + ks * 16 + lh * 8];
#pragma unroll
      for (int mt = 0; mt < 2; ++mt)
#pragma unroll
        for (int nt = 0; nt < 2; ++nt) acc[0][mt][nt] = __builtin_amdgcn_mfma_f32_32x32x16_bf16(af[mt], bfr[nt], acc[0][mt][nt], 0, 0, 0);
    }
    __syncthreads();
    }
  }
  }
  int eM = wm * 64 + lh * 4, eN = l31;
  asm volatile("" : "+v"(eM), "+v"(eN));
  if constexpr (PAIR) {
#pragma unroll
    for (int mt = 0; mt < 2; ++mt)
#pragma unroll
      for (int rg = 0; rg < 4; ++rg) {
        float v[2][4];
#pragma unroll
        for (int i = 0; i < 4; ++i) { v[0][i] = acc[0][mt][0][rg * 4 + i]; v[1][i] = acc[0][mt][1][rg * 4 + i]; }
        ep(eM + mt * 32 + rg * 8, wn * 32 + eN, v);
      }
  } else {
#pragma unroll
    for (int mt = 0; mt < 2; ++mt)
#pragma unroll
      for (int nt = 0; nt < 2; ++nt)
#pragma unroll
        for (int rg = 0; rg < 4; ++rg) {
          float v[NB][4];
#pragma unroll
          for (int b = 0; b < NB; ++b)
#pragma unroll
            for (int i = 0; i < 4; ++i) v[b][i] = acc[b][mt][nt][rg * 4 + i];
          ep(eM + mt * 32 + rg * 8, wn * 64 + nt * 32 + eN, v);
        }
  }
}
template <int NB, class AL, class BL, class EP>
__device__ __forceinline__ void gemm_tile(int tid_, int K, AL al, BL bl, EP ep) { gemm_core<NB, false>(tid_, K, al, bl, ep); }

__device__ __forceinline__ void tile_mn(int T, int Mt, int Nt, int& mt, int& nt) {
  const int g = T / (Mt * 4), rem = T - g * Mt * 4;
  const int gs = (Nt - 4 * g) < 4 ? (Nt - 4 * g) : 4;
  mt = rem / gs; nt = 4 * g + rem % gs;
}

__device__ __forceinline__ void ada_range(const C& p, int t_first, int t_step, int t_end) {
  const int tid = p.tid;
  float* sc = (float*)smem;
  float* red = sc + 3072;
  const float* cc = p.in[5]; const float* cctx = p.in[6];
  for (int i = tid; i < 3072; i += 256) {
    int r = i >> 10, k = i & 1023;
    float c = (r == 0) ? cctx[k] : cc[(r - 1) * 1024 + k];
    sc[i] = c / (1.f + expf(-c));
  }
  __syncthreads();
  float* mod = (float*)(p.ws + WS_MOD);
  for (int t = t_first; t < t_end; t += t_step) {
    const int layer = t / 192, c0 = (t % 192) * 32;
    const int cg = tid & 7, kg = tid >> 3;
    const float* W = p.in[7] + (size_t)layer * 1024 * 6144 + c0 + cg * 4;
    float a[3][4];
#pragma unroll
    for (int r = 0; r < 3; ++r)
#pragma unroll
      for (int j = 0; j < 4; ++j) a[r][j] = 0.f;
#pragma unroll 8
    for (int kk = 0; kk < 32; ++kk) {
      const int k = kg * 32 + kk;
      const float4 w = *(const float4*)(W + (size_t)k * 6144);
#pragma unroll
      for (int r = 0; r < 3; ++r) {
        const float s = sc[r * 1024 + k];
        a[r][0] += s * w.x; a[r][1] += s * w.y; a[r][2] += s * w.z; a[r][3] += s * w.w;
      }
    }
#pragma unroll
    for (int r = 0; r < 3; ++r)
#pragma unroll
      for (int j = 0; j < 4; ++j) red[(kg * 3 + r) * 32 + cg * 4 + j] = a[r][j];
    __syncthreads();
    if (tid < 96) {
      const int r = tid >> 5, c = tid & 31;
      float s = 0.f;
#pragma unroll
      for (int g = 0; g < 32; ++g) s += red[(g * 3 + r) * 32 + c];
      mod[(size_t)(layer * 3 + r) * 6144 + c0 + c] = s + p.in[8][layer * 6144 + c0 + c];
    }
    __syncthreads();
  }
}
__device__ __forceinline__ void ph_ada(const C& p) {
  const int tid = p.tid;
  ada_range(p, p.bid, p.nb, p.nb > 384 ? 192 : 384);
  if (p.bid == p.nb - 1) {
    float* tab = (float*)(p.ws + WS_ROPE);
    for (int i = tid; i < 1024; i += 256) {
      const int pos = i >> 4, f = i & 15;
      const float ang = (float)pos * powf(10000.f, -(float)f / 16.f);
      tab[i * 2] = cosf(ang); tab[i * 2 + 1] = sinf(ang);
    }
  }
}

__device__ __forceinline__ void moe_combine_row(const C& p, int tok, int ml, int lane, float4 (&xv)[4]) {
  const int* SEL = (const int*)(p.ws + WS_SEL);
  const float* aff = (const float*)(p.ws + WS_AFF);
  const float* mod = (const float*)(p.ws + WS_MOD);
  const bf16_t* YE = (const bf16_t*)(p.ws + WS_YE);
  const int grp = tok >= NPR, nloc = tok - grp * NPR;
  float4 acc[4];
#pragma unroll
  for (int i = 0; i < 4; ++i) acc[i] = make_float4(0.f, 0.f, 0.f, 0.f);
  int sl[16]; float gts[16];
#pragma unroll
  for (int q = 0; q < 4; ++q) { const int4 v = *(const int4*)(SEL + tok * 16 + q * 4); sl[q * 4] = v.x; sl[q * 4 + 1] = v.y; sl[q * 4 + 2] = v.z; sl[q * 4 + 3] = v.w; }
#pragma unroll
  for (int e = 0; e < 16; ++e) gts[e] = aff[(size_t)(grp * 16 + e) * 4096 + nloc];
#pragma unroll
  for (int e = 0; e < 16; ++e) {
    const int slot = sl[e];
    if (slot >= 0) {
      const float gt = gts[e];
      const bf16_t* ye = YE + (size_t)(e * 768 + slot) * 1024;
#pragma unroll
      for (int i = 0; i < 4; ++i) {
        const uint2 w = *(const uint2*)(ye + (i * 64 + lane) * 4);
        acc[i].x += gt * __uint_as_float(w.x << 16); acc[i].y += gt * __uint_as_float(w.x & 0xffff0000u);
        acc[i].z += gt * __uint_as_float(w.y << 16); acc[i].w += gt * __uint_as_float(w.y & 0xffff0000u);
      }
    }
  }
  const float* g5 = mod + (size_t)(ml * 3 + modrow(tok)) * 6144 + 5 * 1024;
#pragma unroll
  for (int i = 0; i < 4; ++i) {
    const float4 gv = *(const float4*)(g5 + (i * 64 + lane) * 4);
    xv[i].x += gv.x * acc[i].x; xv[i].y += gv.y * acc[i].y; xv[i].z += gv.z * acc[i].z; xv[i].w += gv.w * acc[i].w;
  }
}

template <bool ROUTER>
__device__ __forceinline__ void ph_prep(const C& p, bool from_inputs, const float* g, int layer, int slot_shift, const float* rw) {
  const int tid = p.tid, lane = tid & 63, wave = tid >> 6;
  const float* mod = (const float*)(p.ws + WS_MOD);
  const float* xcur = (const float*)(p.ws + WS_XCUR);
  bf16_t* H = (bf16_t*)(p.ws + WS_H);
  float* aff = (float*)(p.ws + WS_AFF);
  for (int tok = p.bid * 4 + wave; tok < NTOK; tok += p.nb * 4) {
    const float* x = from_inputs ? (tok < NPR ? p.in[0] + (size_t)tok * DM : p.in[1] + (size_t)(tok - NPR) * DM) : xcur + (size_t)tok * DM;
    const int mr = modrow(tok);
    const float* sh = mod + (size_t)(layer * 3 + mr) * 6144 + slot_shift * 1024;
    const float* scl = sh + 1024;
    float4 xv[4];
    float ss = 0.f;
#pragma unroll
    for (int i = 0; i < 4; ++i) xv[i] = *(const float4*)(x + (i * 64 + lane) * 4);
    if (!ROUTER && !from_inputs) {
      moe_combine_row(p, tok, 0, lane, xv);
      float* xw = (float*)(p.ws + WS_XCUR) + (size_t)tok * DM;
#pragma unroll
      for (int i = 0; i < 4; ++i) *(float4*)(xw + (i * 64 + lane) * 4) = xv[i];
    }
    if (ROUTER) { if (lane < 16) ((int*)(p.ws + WS_SEL))[tok * 16 + lane] = -1; }
#pragma unroll
    for (int i = 0; i < 4; ++i) ss += xv[i].x * xv[i].x + xv[i].y * xv[i].y + xv[i].z * xv[i].z + xv[i].w * xv[i].w;
    ss = wave_sum(ss, lane);
    const float rinv = rsqrtf(ss * (1.f / 1024.f) + RMS_EPS);
    float lg[16];
    if (ROUTER) {
#pragma unroll
      for (int e = 0; e < 16; ++e) lg[e] = 0.f;
    }
#pragma unroll
    for (int i = 0; i < 4; ++i) {
      const int d = (i * 64 + lane) * 4;
      const float4 gv = *(const float4*)(g + d), sv = *(const float4*)(sh + d), cv = *(const float4*)(scl + d);
      float h[4];
      h[0] = xv[i].x * rinv * gv.x * (1.f + cv.x) + sv.x;
      h[1] = xv[i].y * rinv * gv.y * (1.f + cv.y) + sv.y;
      h[2] = xv[i].z * rinv * gv.z * (1.f + cv.z) + sv.z;
      h[3] = xv[i].w * rinv * gv.w * (1.f + cv.w) + sv.w;
      uint2 o; o.x = pk2(h[0], h[1]); o.y = pk2(h[2], h[3]);
      *(uint2*)(H + (size_t)tok * DM + d) = o;
      if (ROUTER) {
#pragma unroll
        for (int j = 0; j < 4; ++j) {
          const float4* rr = (const float4*)(rw + (size_t)(d + j) * 16);
#pragma unroll
          for (int q = 0; q < 4; ++q) {
            const float4 w = rr[q];
            lg[q * 4 + 0] += h[j] * w.x; lg[q * 4 + 1] += h[j] * w.y; lg[q * 4 + 2] += h[j] * w.z; lg[q * 4 + 3] += h[j] * w.w;
          }
        }
      }
    }
    if (ROUTER) {
      float mx = -1e30f;
#pragma unroll
      for (int e = 0; e < 16; ++e) { lg[e] = wave_sum(lg[e], lane); mx = fmaxf(mx, lg[e]); }
      float se = 0.f;
#pragma unroll
      for (int e = 0; e < 16; ++e) { lg[e] = expf(lg[e] - mx); se += lg[e]; }
      const float inv = 1.f / se;
      const int grp = tok >= NPR, nloc = tok - grp * NPR;
      float mine = 0.f;
#pragma unroll
      for (int e = 0; e < 16; ++e) mine = (lane == e) ? lg[e] * inv : mine;
      if (lane < 16) aff[(size_t)(grp * 16 + lane) * 4096 + nloc] = mine;
    }
  }
}

__device__ __forceinline__ void ph_router(const C& p, const float* g, int layer, const float* rw) {
  const int tid = p.tid, lane = tid & 63, wave = tid >> 6;
  const float* mod = (const float*)(p.ws + WS_MOD);
  const float* xcur = (const float*)(p.ws + WS_XCUR);
  bf16_t* H = (bf16_t*)(p.ws + WS_H);
  float* aff = (float*)(p.ws + WS_AFF);
  int* SEL = (int*)(p.ws + WS_SEL);
  for (int base = (p.bid * 4 + wave) * 3; base < NTOK; base += p.nb * 12) {
    float rinv[3]; const float* sh[3];
#pragma unroll
    for (int j = 0; j < 3; ++j) {
      const int tok = base + j;
      const float* x = xcur + (size_t)tok * DM;
      float ss = 0.f;
#pragma unroll
      for (int i = 0; i < 4; ++i) { const float4 v = *(const float4*)(x + (i * 64 + lane) * 4); ss += v.x * v.x + v.y * v.y + v.z * v.z + v.w * v.w; }
      ss = wave_sum(ss, lane);
      rinv[j] = rsqrtf(ss * (1.f / 1024.f) + RMS_EPS);
      sh[j] = mod + (size_t)(layer * 3 + modrow(tok)) * 6144 + 3 * 1024;
      if (lane < 16) SEL[tok * 16 + lane] = -1;
    }
    float lg[3][16];
#pragma unroll
    for (int j = 0; j < 3; ++j)
#pragma unroll
      for (int e = 0; e < 16; ++e) lg[j][e] = 0.f;
#pragma unroll 1
    for (int i = 0; i < 4; ++i) {
      const int d = (i * 64 + lane) * 4;
      const float4 gv = *(const float4*)(g + d);
      float h[3][4];
#pragma unroll
      for (int j = 0; j < 3; ++j) {
        const float4 xq = *(const float4*)(xcur + (size_t)(base + j) * DM + d);
        const float4 sv = *(const float4*)(sh[j] + d), cv = *(const float4*)(sh[j] + 1024 + d);
        h[j][0] = xq.x * rinv[j] * gv.x * (1.f + cv.x) + sv.x;
        h[j][1] = xq.y * rinv[j] * gv.y * (1.f + cv.y) + sv.y;
        h[j][2] = xq.z * rinv[j] * gv.z * (1.f + cv.z) + sv.z;
        h[j][3] = xq.w * rinv[j] * gv.w * (1.f + cv.w) + sv.w;
        uint2 o; o.x = pk2(h[j][0], h[j][1]); o.y = pk2(h[j][2], h[j][3]);
        *(uint2*)(H + (size_t)(base + j) * DM + d) = o;
      }
#pragma unroll
      for (int jj = 0; jj < 4; ++jj) {
        const float4* rr = (const float4*)(rw + (size_t)(d + jj) * 16);
#pragma unroll
        for (int q = 0; q < 4; ++q) {
          const float4 w = rr[q];
#pragma unroll
          for (int j = 0; j < 3; ++j) {
            lg[j][q * 4 + 0] += h[j][jj] * w.x; lg[j][q * 4 + 1] += h[j][jj] * w.y; lg[j][q * 4 + 2] += h[j][jj] * w.z; lg[j][q * 4 + 3] += h[j][jj] * w.w;
          }
        }
      }
    }
#pragma unroll
    for (int j = 0; j < 3; ++j) {
      const int tok = base + j;
      float mx = -1e30f;
#pragma unroll
      for (int e = 0; e < 16; ++e) { lg[j][e] = wave_sum(lg[j][e], lane); mx = fmaxf(mx, lg[j][e]); }
      float se = 0.f;
#pragma unroll
      for (int e = 0; e < 16; ++e) { lg[j][e] = expf(lg[j][e] - mx); se += lg[j][e]; }
      const float inv = 1.f / se;
      const int grp = tok >= NPR, nloc = tok - grp * NPR;
      float mine = 0.f;
#pragma unroll
      for (int e = 0; e < 16; ++e) mine = (lane == e) ? lg[j][e] * inv : mine;
      if (lane < 16) aff[(size_t)(grp * 16 + lane) * 4096 + nloc] = mine;
    }
  }
}

__device__ __forceinline__ void ph_gemm_in0(const C& p) {
  const bf16_t* H = (const bf16_t*)(p.ws + WS_H);
  const float* W = p.in[11];
  float* Z = (float*)(p.ws + WS_Z);
  for (int t = p.vb; t < 48 * 27; t += p.nb) {
    int mt_, nt_; tile_mn(t, 48, 27, mt_, nt_);
    const int m0 = mt_ * 128, n0 = nt_ * 128;
    gemm_tile<1>(p.tid, 1024,
      [=](int m, int k) { return *(const uint4*)(H + (size_t)(m0 + m) * DM + k); },
      [=](int, int k, int n) { return ldg4(W, (unsigned)(k * IN0C + n0 + n)); },
      [=](int m, int n, const float (&v)[1][4]) {
#pragma unroll
        for (int i = 0; i < 4; ++i) Z[(size_t)(m0 + m + i) * IN0C + n0 + n] = v[0][i];
      });
  }
}

__device__ __forceinline__ void ph_mix(const C& p) {
  const int tid = p.tid, lane = tid & 63, wave = tid >> 6;
  const float* Z = (const float*)(p.ws + WS_Z);
  float* ZM = (float*)(p.ws + WS_ZM);
  float* OA = (float*)(p.ws + WS_OPSA);
  bf16_t* YC = (bf16_t*)(p.ws + WS_YCAT);
  const float* cw = p.in[12]; const float* mu = p.in[13]; const float* kk_w = p.in[19];
  for (int tok = p.bid * 4 + wave; tok < NTOK; tok += p.nb * 4) {
    int t, T;
    if (tok < NPR) { t = tok & 255; T = 256; } else { t = (tok - NPR) & 1023; T = 1024; }
    const bool hasL = t > 0, hasR = t < T - 1;
    const float* zc = Z + (size_t)tok * IN0C;
    const float* zl = zc - IN0C; const float* zr = zc + IN0C;
    {
      const int c = lane * 8;
      float o[8];
#pragma unroll
      for (int q = 0; q < 2; ++q) {
        const int cq = c + q * 4;
        const float4 gb = *(const float4*)(zc + cq);
        const float4 gc = *(const float4*)(zc + 512 + cq), xa = *(const float4*)(zc + 1024 + cq);
        float4 ul = make_float4(0.f, 0.f, 0.f, 0.f), ur = ul;
        if (hasL) { const float4 a = *(const float4*)(zl + 512 + cq), b = *(const float4*)(zl + 1024 + cq); ul = make_float4(a.x * b.x, a.y * b.y, a.z * b.z, a.w * b.w); }
        if (hasR) { const float4 a = *(const float4*)(zr + 512 + cq), b = *(const float4*)(zr + 1024 + cq); ur = make_float4(a.x * b.x, a.y * b.y, a.z * b.z, a.w * b.w); }
        const float4 w0 = *(const float4*)(cw + cq), w1 = *(const float4*)(cw + 512 + cq), w2 = *(const float4*)(cw + 1024 + cq);
        o[q * 4 + 0] = gb.x * (w0.x * ul.x + w1.x * gc.x * xa.x + w2.x * ur.x);
        o[q * 4 + 1] = gb.y * (w0.y * ul.y + w1.y * gc.y * xa.y + w2.y * ur.y);
        o[q * 4 + 2] = gb.z * (w0.z * ul.z + w1.z * gc.z * xa.z + w2.z * ur.z);
        o[q * 4 + 3] = gb.w * (w0.w * ul.w + w1.w * gc.w * xa.w + w2.w * ur.w);
      }
      uint4 w; w.x = pk2(o[0], o[1]); w.y = pk2(o[2], o[3]); w.z = pk2(o[4], o[5]); w.w = pk2(o[6], o[7]);
      *(uint4*)(YC + (size_t)tok * DM + c) = w;
    }
#pragma unroll
    for (int i = 0; i < 8; ++i) {
      const int c = i * 256 + lane * 4;
      if (c < ZMC) {
        const float4 a = *(const float4*)(zc + 1536 + c);
        float4 l = make_float4(0.f, 0.f, 0.f, 0.f), r = l;
        if (hasL) l = *(const float4*)(zl + 1536 + c);
        if (hasR) r = *(const float4*)(zr + 1536 + c);
        const float4 m = *(const float4*)(mu + c);
        float4 o;
        o.x = a.x + m.x * (0.5f * (l.x + r.x) - a.x);
        o.y = a.y + m.y * (0.5f * (l.y + r.y) - a.y);
        o.z = a.z + m.z * (0.5f * (l.z + r.z) - a.z);
        o.w = a.w + m.w * (0.5f * (l.w + r.w) - a.w);
        *(float4*)(ZM + (size_t)tok * ZMC + c) = o;
        if (i < 2) {
          const int h = c >> 6, j = c & 63;
          *(float4*)(OA + ((size_t)(tok * 8 + h) * 2 + 1) * 64 + j) = o;
        } else if (i < 4) {
          const int ck = c - 512;
          const float4 kw = *(const float4*)(kk_w + ck);
          float4 q = make_float4(o.x * kw.x, o.y * kw.y, o.z * kw.z, o.w * kw.w);
          float ss = q.x * q.x + q.y * q.y + q.z * q.z + q.w * q.w;
          ss += swz<1>(ss); ss += swz<2>(ss); ss += swz<4>(ss); ss += swz<8>(ss);
          const float rn = -rsqrtf(fmaxf(ss, 1e-12f));
          q.x *= rn; q.y *= rn; q.z *= rn; q.w *= rn;
          const int h = ck >> 6, j = ck & 63;
          *(float4*)(OA + ((size_t)(tok * 8 + h) * 2 + 0) * 64 + j) = q;
        }
      }
    }
  }
}

__device__ __forceinline__ void ph_lora(const C& p) {
  const float* ZM = (const float*)(p.ws + WS_ZM);
  const float* OA = (const float*)(p.ws + WS_OPSA);
  float* OB = (float*)(p.ws + WS_OPSB);
  float* GG = (float*)(p.ws + WS_GG);
  for (int t = p.vb; t < 960; t += p.nb) {
    const int g = t / 192, rem = t % 192;
    const int m0 = (rem >> 2) * 128, n0 = (rem & 3) * 128;
    if (g < 2) {
      const int d = g;
      const float* W = p.in[15] + (size_t)d * 64 * 512;
      const float* w0 = p.in[14] + d * 512;
      gemm_tile<1>(p.tid, 64,
        [=](int m, int k) {
          const float* s = ZM + (size_t)(m0 + m) * ZMC + 1536 + d * 64 + k;
          const float4 a = *(const float4*)s, b = *(const float4*)(s + 4);
          uint4 o; o.x = pk2(tanhf(a.x), tanhf(a.y)); o.y = pk2(tanhf(a.z), tanhf(a.w)); o.z = pk2(tanhf(b.x), tanhf(b.y)); o.w = pk2(tanhf(b.z), tanhf(b.w));
          return o; },
        [=](int, int k, int n) { return ldg4(W, (unsigned)(k * 512 + n0 + n)); },
        [=](int m, int n, const float (&v)[1][4]) {
          const int nn = n0 + n, h = nn >> 6, j = nn & 63;
          const float b0 = w0[nn];
#pragma unroll
          for (int i = 0; i < 4; ++i) {
            const int tok = m0 + m + i;
            OB[(((size_t)d * NTOK + tok) * 8 + h) * 192 + j] = expf(-DECAY_SCALE * sigmoidf_(b0 + v[0][i]));
          }
        });
    } else if (g < 4) {
      const int d = g - 2;
      const float* W = p.in[17] + (size_t)d * 64 * 512;
      const float* a0 = p.in[16] + d * 512;
      const float* ka = p.in[20];
      gemm_tile<1>(p.tid, 64,
        [=](int m, int k) {
          const float* s = ZM + (size_t)(m0 + m) * ZMC + 1664 + d * 64 + k;
          const float4 a = *(const float4*)s, b = *(const float4*)(s + 4);
          uint4 o; o.x = pk2(a.x, a.y); o.y = pk2(a.z, a.w); o.z = pk2(b.x, b.y); o.w = pk2(b.z, b.w);
          return o; },
        [=](int, int k, int n) { return ldg4(W, (unsigned)(k * 512 + n0 + n)); },
        [=](int m, int n, const float (&v)[1][4]) {
          const int nn = n0 + n, h = nn >> 6, j = nn & 63;
          const float b0 = a0[nn];
#pragma unroll
          for (int i = 0; i < 4; ++i) {
            const int tok = m0 + m + i;
            OB[(((size_t)d * NTOK + tok) * 8 + h) * 192 + 64 + j] = sigmoidf_(b0 + v[0][i]);
          }
        });
    } else {
      const float* W = p.in[18];
      gemm_tile<1>(p.tid, 128,
        [=](int m, int k) {
          const float* s = ZM + (size_t)(m0 + m) * ZMC + 1792 + k;
          const float4 a = *(const float4*)s, b = *(const float4*)(s + 4);
          uint4 o; o.x = pk2(sigmoidf_(a.x), sigmoidf_(a.y)); o.y = pk2(sigmoidf_(a.z), sigmoidf_(a.w)); o.z = pk2(sigmoidf_(b.x), sigmoidf_(b.y)); o.w = pk2(sigmoidf_(b.z), sigmoidf_(b.w));
          return o; },
        [=](int, int k, int n) { return ldg4(W, (unsigned)(k * 512 + n0 + n)); },
        [=](int m, int n, const float (&v)[1][4]) {
#pragma unroll
          for (int i = 0; i < 4; ++i) GG[(size_t)(m0 + m + i) * 512 + n0 + n] = v[0][i];
        });
    }
  }
}

#define CH_L 128
__device__ __forceinline__ int pq_entry(int ch, int c) { return ch < 32 ? ch * 8 + c : 256 + (ch - 32) * 2 + c; }
__device__ __forceinline__ void ph_scan(const C& p) {
  const int lane = p.tid & 63;
  const int wave = __builtin_amdgcn_readfirstlane(p.tid >> 6);
  const float* ZM = (const float*)(p.ws + WS_ZM);
  const float* OA = (const float*)(p.ws + WS_OPSA);
  const float* OB = (const float*)(p.ws + WS_OPSB);
  float* YD = (float*)(p.ws + WS_YD);
  float* UD = (float*)(p.ws + WS_UD);
  float* PQ = (float*)(p.ws + WS_PQ);
  const int d = wave >> 1, ident = wave & 1;
  for (int it = p.bid; it < 384; it += p.nb) {
    int b, h, c, T, tok0, ch;
    if (it < 128) { b = it >> 6; h = (it >> 3) & 7; c = it & 7; T = 1024; tok0 = NPR + b * 1024; ch = (b * 8 + h) * 2 + d; }
    else { const int i2 = it - 128; b = i2 >> 4; h = (i2 >> 1) & 7; c = i2 & 1; T = 256; tok0 = b * 256; ch = 32 + (b * 8 + h) * 2 + d; }
    if (ident && c == 0) continue;
    float S[64];
    if (ident) {
#pragma unroll
      for (int k = 0; k < 64; ++k) S[k] = (k == lane) ? 1.f : 0.f;
    } else if (c == 0 && it < 128) {
      const float* s0 = p.in[2] + ((size_t)((b * 2 + d) * 8 + h) * 64 + lane) * 64;
#pragma unroll
      for (int k = 0; k < 64; k += 4) { const float4 v = *(const float4*)(s0 + k); S[k] = v.x; S[k + 1] = v.y; S[k + 2] = v.z; S[k + 3] = v.w; }
    } else {
#pragma unroll
      for (int k = 0; k < 64; ++k) S[k] = 0.f;
    }
    const int tinc = d ? -1 : 1;
    const int tokA = tok0 + (d ? T - 1 - c * CH_L : c * CH_L);
    float* yout = ident ? UD : YD;
    float ob[4][5], vb[4];
    const float ka_l = p.in[20][h * 64 + lane];
    auto fetch = [&](int j, int sidx) {
      const int sc = sidx < CH_L ? sidx : CH_L - 1;
      const int tk = tokA + sc * tinc;
      const float* pa = OA + (size_t)(tk * 8 + h) * 128 + lane;
      const float* pb = OB + (((size_t)d * NTOK + tk) * 8 + h) * 192 + lane;
      const float nk_ = pa[0], a_ = pb[64], kp_ = ZM[(size_t)tk * ZMC + 512 + h * 64 + lane];
      ob[j][0] = nk_; ob[j][1] = pa[64]; ob[j][2] = pb[0];
      ob[j][3] = -nk_ * a_;
      ob[j][4] = kp_ * (1.f + (a_ - 1.f) * ka_l);
      vb[j] = ident ? 0.f : ZM[(size_t)tk * ZMC + 1024 + h * 64 + lane];
    };
#pragma unroll
    for (int j = 0; j < 4; ++j) fetch(j, j);
#pragma unroll 1
    for (int s0 = 0; s0 < CH_L; s0 += 4) {
#pragma unroll
      for (int j = 0; j < 4; ++j) {
        const int tok = tokA + (s0 + j) * tinc;
        const int i_nkk = __builtin_bit_cast(int, ob[j][0]), i_r = __builtin_bit_cast(int, ob[j][1]);
        const int i_w = __builtin_bit_cast(int, ob[j][2]), i_b = __builtin_bit_cast(int, ob[j][3]), i_kd = __builtin_bit_cast(int, ob[j][4]);
        const float vv = vb[j];
        float sa0 = 0.f, sa1 = 0.f;
#pragma unroll
        for (int k = 0; k < 64; k += 2) {
          sa0 += S[k] * __builtin_bit_cast(float, __builtin_amdgcn_readlane(i_nkk, k));
          sa1 += S[k + 1] * __builtin_bit_cast(float, __builtin_amdgcn_readlane(i_nkk, k + 1));
        }
        const float sa = sa0 + sa1;
        float y0 = 0.f, y1 = 0.f;
#pragma unroll
        for (int k = 0; k < 64; k += 2) {
          S[k] = S[k] * __builtin_bit_cast(float, __builtin_amdgcn_readlane(i_w, k))
               + (sa * __builtin_bit_cast(float, __builtin_amdgcn_readlane(i_b, k)) + vv * __builtin_bit_cast(float, __builtin_amdgcn_readlane(i_kd, k)));
          S[k + 1] = S[k + 1] * __builtin_bit_cast(float, __builtin_amdgcn_readlane(i_w, k + 1))
               + (sa * __builtin_bit_cast(float, __builtin_amdgcn_readlane(i_b, k + 1)) + vv * __builtin_bit_cast(float, __builtin_amdgcn_readlane(i_kd, k + 1)));
          y0 += S[k] * __builtin_bit_cast(float, __builtin_amdgcn_readlane(i_r, k));
          y1 += S[k + 1] * __builtin_bit_cast(float, __builtin_amdgcn_readlane(i_r, k + 1));
        }
        yout[((size_t)d * NTOK + tok) * 512 + h * 64 + lane] = y0 + y1;
        fetch(j, s0 + j + 4);
      }
    }
    float* so = PQ + ((size_t)pq_entry(ch, c) * 2 + (ident ? 0 : 1)) * 4096 + lane * 64;
#pragma unroll
    for (int k = 0; k < 64; k += 4) *(float4*)(so + k) = make_float4(S[k], S[k + 1], S[k + 2], S[k + 3]);
  }
  if (p.nb > 384 && p.bid >= 384) ada_range(p, 192 + (p.bid - 384), p.nb - 384, 384);
}

__device__ __forceinline__ void ph_scanfix(const C& p) {
  const int tid = p.tid, lane = tid & 63, wave = tid >> 6;
  float* Sa = (float*)smem;
  float* Sb = Sa + 64 * 65;
  float* Pl = Sb + 64 * 65;
  float* YD = (float*)(p.ws + WS_YD);
  const float* UD = (const float*)(p.ws + WS_UD);
  const float* PQ = (const float*)(p.ws + WS_PQ);
  for (int it = p.bid; it < 480; it += p.nb) {
    int ch, c, nch;
    if (it < 224) { ch = it / 7; c = 1 + it % 7; nch = 8; } else { ch = 32 + (it - 224); c = 1; nch = 2; }
    int b, h, d, T, tok0;
    if (ch < 32) { b = ch >> 4; h = (ch >> 1) & 7; d = ch & 1; T = 1024; tok0 = NPR + b * 1024; }
    else { const int c2 = ch - 32; b = c2 >> 4; h = (c2 >> 1) & 7; d = c2 & 1; T = 256; tok0 = b * 256; }
    { const float* q0 = PQ + ((size_t)pq_entry(ch, 0) * 2 + 1) * 4096;
      for (int i = tid; i < 4096; i += 256) Sa[(i >> 6) * 65 + (i & 63)] = q0[i]; }
    float* cur = Sa; float* nxt = Sb;
    const bool emit = (ch >= 32) && (c == nch - 1);
    const int nmul = (c - 1) + (emit ? 1 : 0);
    const int v = tid >> 2, kq = (tid & 3) * 16;
    for (int m = 0; m < nmul; ++m) {
      const int cc = 1 + m;
      const float* Pg = PQ + ((size_t)pq_entry(ch, cc) * 2 + 0) * 4096;
      const float* Qg = Pg + 4096;
      __syncthreads();
      for (int i = tid; i < 1024; i += 256) *(float4*)(Pl + i * 4) = *(const float4*)(Pg + i * 4);
      __syncthreads();
      float acc[16];
#pragma unroll
      for (int j = 0; j < 16; j += 4) { const float4 q = *(const float4*)(Qg + v * 64 + kq + j); acc[j] = q.x; acc[j + 1] = q.y; acc[j + 2] = q.z; acc[j + 3] = q.w; }
      for (int i = 0; i < 64; ++i) {
        const float a = cur[v * 65 + i];
#pragma unroll
        for (int j = 0; j < 16; j += 4) {
          const float4 pv = *(const float4*)(Pl + i * 64 + kq + j);
          acc[j] += a * pv.x; acc[j + 1] += a * pv.y; acc[j + 2] += a * pv.z; acc[j + 3] += a * pv.w;
        }
      }
      if (emit && m == nmul - 1) {
        float* so = p.out + O_ST + ((size_t)((b * 2 + d) * 8 + h) * 64 + v) * 64 + kq;
#pragma unroll
        for (int j = 0; j < 16; j += 4) *(float4*)(so + j) = make_float4(acc[j], acc[j + 1], acc[j + 2], acc[j + 3]);
      } else {
#pragma unroll
        for (int j = 0; j < 16; ++j) nxt[v * 65 + kq + j] = acc[j];
        float* t = cur; cur = nxt; nxt = t;
      }
    }
    __syncthreads();
    float sr[64];
#pragma unroll
    for (int i = 0; i < 64; ++i) sr[i] = cur[lane * 65 + i];
    __syncthreads();
    float* Ul = Sb + wave * 2048;
    const int tinc = d ? -1 : 1;
    const int tokA = tok0 + (d ? T - 1 - c * CH_L : c * CH_L);
    {
      float uv[32];
#pragma unroll
      for (int s = 0; s < 32; ++s) uv[s] = UD[((size_t)d * NTOK + (tokA + (wave * 32 + s) * tinc)) * 512 + h * 64 + lane];
#pragma unroll
      for (int s = 0; s < 32; ++s) Ul[s * 64 + lane] = uv[s];
    }
    __syncthreads();
    float yv[32];
#pragma unroll
    for (int s = 0; s < 32; ++s) yv[s] = YD[((size_t)d * NTOK + (tokA + (wave * 32 + s) * tinc)) * 512 + h * 64 + lane];
#pragma unroll
    for (int s = 0; s < 32; ++s) {
      const int tok = tokA + (wave * 32 + s) * tinc;
      float a0 = 0.f, a1 = 0.f;
#pragma unroll
      for (int i = 0; i < 64; i += 4) {
        const float4 u = *(const float4*)(Ul + s * 64 + i);
        a0 += sr[i] * u.x; a1 += sr[i + 1] * u.y; a0 += sr[i + 2] * u.z; a1 += sr[i + 3] * u.w;
      }
      YD[((size_t)d * NTOK + tok) * 512 + h * 64 + lane] = yv[s] + (a0 + a1);
    }
    __syncthreads();
  }
}

__device__ __forceinline__ void ph_post(const C& p) {
  const int tid = p.tid, lane = tid & 63, wave = tid >> 6;
  const float* ZM = (const float*)(p.ws + WS_ZM);
  const float* YD = (const float*)(p.ws + WS_YD);
  const float* GG = (const float*)(p.ws + WS_GG);
  bf16_t* YC = (bf16_t*)(p.ws + WS_YCAT);
  const float* rk = p.in[21]; const float* lnw = p.in[22]; const float* lnb = p.in[23];
  for (int tok = p.bid * 4 + wave; tok < NTOK; tok += p.nb * 4) {
    const int c = lane * 8;
    float y[8], r[8], k[8], v[8], g[8];
#pragma unroll
    for (int q = 0; q < 2; ++q) {
      const float4 a = *(const float4*)(YD + (size_t)tok * 512 + c + q * 4), b = *(const float4*)(YD + ((size_t)NTOK + tok) * 512 + c + q * 4);
      y[q * 4] = a.x + b.x; y[q * 4 + 1] = a.y + b.y; y[q * 4 + 2] = a.z + b.z; y[q * 4 + 3] = a.w + b.w;
      const float4 rr = *(const float4*)(ZM + (size_t)tok * ZMC + c + q * 4), kk = *(const float4*)(ZM + (size_t)tok * ZMC + 512 + c + q * 4), vv = *(const float4*)(ZM + (size_t)tok * ZMC + 1024 + c + q * 4);
      r[q * 4] = rr.x; r[q * 4 + 1] = rr.y; r[q * 4 + 2] = rr.z; r[q * 4 + 3] = rr.w;
      k[q * 4] = kk.x; k[q * 4 + 1] = kk.y; k[q * 4 + 2] = kk.z; k[q * 4 + 3] = kk.w;
      v[q * 4] = vv.x; v[q * 4 + 1] = vv.y; v[q * 4 + 2] = vv.z; v[q * 4 + 3] = vv.w;
      const float4 gg = *(const float4*)(GG + (size_t)tok * 512 + c + q * 4);
      g[q * 4] = gg.x; g[q * 4 + 1] = gg.y; g[q * 4 + 2] = gg.z; g[q * 4 + 3] = gg.w;
    }
    float sm = 0.f, bn = 0.f;
#pragma unroll
    for (int i = 0; i < 8; ++i) { sm += y[i]; bn += r[i] * k[i] * rk[c + i]; }
    sm += swz<1>(sm); sm += swz<2>(sm); sm += swz<4>(sm);
    bn += swz<1>(bn); bn += swz<2>(bn); bn += swz<4>(bn);
    const float mean = sm * (1.f / 64.f);
    float vr = 0.f;
#pragma unroll
    for (int i = 0; i < 8; ++i) { const float dd = y[i] - mean; vr += dd * dd; }
    vr += swz<1>(vr); vr += swz<2>(vr); vr += swz<4>(vr);
    const float rs = rsqrtf(vr * (1.f / 64.f) + GN_EPS);
    float o[8];
#pragma unroll
    for (int i = 0; i < 8; ++i) o[i] = ((y[i] - mean) * rs * lnw[c + i] + lnb[c + i] + bn * v[i]) * g[i];
    uint4 w; w.x = pk2(o[0], o[1]); w.y = pk2(o[2], o[3]); w.z = pk2(o[4], o[5]); w.w = pk2(o[6], o[7]);
    *(uint4*)(YC + (size_t)tok * DM + 512 + c) = w;
  }
}

__device__ __forceinline__ void ph_gemm_out(const C& p, const float* W, int layer, bool from_inputs) {
  const bf16_t* A = (const bf16_t*)(p.ws + WS_YCAT);
  const float* mod = (const float*)(p.ws + WS_MOD);
  float* X = (float*)(p.ws + WS_XCUR);
  for (int t = p.vb; t < 48 * 8; t += p.nb) {
    int mt_, nt_; tile_mn(t, 48, 8, mt_, nt_);
    const int m0 = mt_ * 128, n0 = nt_ * 128;
    const float* gate = mod + (size_t)(layer * 3 + modrow(m0)) * 6144 + 2 * 1024;
    const float* xin = from_inputs ? (m0 < NPR ? p.in[0] + (size_t)m0 * DM : p.in[1] + (size_t)(m0 - NPR) * DM) : X + (size_t)m0 * DM;
    const float* xr_ = xin + (size_t)(p.tid >> 1) * DM + n0 + (p.tid & 1) * 64;
    const float t0_ = xr_[0], t1_ = xr_[32];
    gemm_tile<1>(p.tid, 1024,
      [=](int m, int k) { return *(const uint4*)(A + (size_t)(m0 + m) * DM + k); },
      [=](int, int k, int n) { return ldg4(W, (unsigned)(k * DM + n0 + n)); },
      [=](int m, int n, const float (&v)[1][4]) {
        const float gt = gate[n0 + n];
#pragma unroll
        for (int i = 0; i < 4; ++i) X[(size_t)(m0 + m + i) * DM + n0 + n] = xin[(size_t)(m + i) * DM + n0 + n] + gt * v[0][i];
      });
    asm volatile("" :: "v"(t0_), "v"(t1_));
  }
}

__device__ __forceinline__ void ph_topk(const C& p) {
  const int tid = p.tid;
  unsigned* keys = (unsigned*)smem;
  unsigned* hist = keys + 4096;
  unsigned* ctl = hist + 256;
  unsigned* gsum = ctl + 8;
  const float* aff = (const float*)(p.ws + WS_AFF);
  int* IDX = (int*)(p.ws + WS_IDX);
  int* SEL = (int*)(p.ws + WS_SEL);
  for (int it = p.bid; it < 32; it += p.nb) {
    const int grp = it >> 4, e = it & 15;
    const int n = grp ? NSA : NPR, cap = n >> 3;
    const float* a = aff + (size_t)(grp * 16 + e) * 4096;
    for (int i = tid; i < n; i += 256) keys[i] = __float_as_uint(a[i]);
    unsigned prefix = 0, mask = 0, need = cap;
    for (int pass = 0; pass < 4; ++pass) {
      const int shift = 24 - 8 * pass;
      hist[tid] = 0;
      __syncthreads();
      for (int i = tid; i < n; i += 256) { const unsigned k = keys[i]; if ((k & mask) == prefix) atomicAdd(&hist[(k >> shift) & 255u], 1u); }
      __syncthreads();
      if (tid < 16) {
        unsigned g = 0;
#pragma unroll
        for (int j = 0; j < 16; ++j) g += hist[tid * 16 + j];
        gsum[tid] = g;
      }
      __syncthreads();
      {
        const unsigned hb = hist[tid];
        const int g = tid >> 4, bl = tid & 15;
        unsigned cum = 0;
#pragma unroll
        for (int q = 1; q < 16; ++q) {
          const unsigned gv = gsum[(g + q) & 15], hv = hist[(tid & ~15) + ((bl + q) & 15)];
          cum += (g + q < 16) ? gv : 0u;
          cum += (bl + q < 16) ? hv : 0u;
        }
        if (cum < need && cum + hb >= need) { ctl[0] = tid; ctl[1] = need - cum; }
      }
      __syncthreads();
      prefix |= ctl[0] << shift; mask |= 255u << shift; need = ctl[1];
      __syncthreads();
    }
    if (tid == 0) { ctl[2] = 0; ctl[3] = 0; }
    __syncthreads();
    const unsigned T = prefix;
    for (int i = tid; i < n; i += 256) if (keys[i] == T) atomicAdd(&ctl[3], 1u);
    __syncthreads();
    const bool all_eq = ctl[3] == need;
    const int obase = e * 768 + (grp ? 512 : 0);
    for (int i = tid; i < n; i += 256) {
      const unsigned k = keys[i];
      bool sel = k > T;
      if (k == T) { if (all_eq) sel = true; else { unsigned rk = 0; for (int j = 0; j < i; ++j) rk += (keys[j] == T); sel = rk < need; } }
      if (sel) {
        const unsigned slot = atomicAdd(&ctl[2], 1u);
        IDX[obase + slot] = i + grp * NPR;
        SEL[(i + grp * NPR) * 16 + e] = (int)(obase - e * 768 + slot);
      }
    }
    __syncthreads();
  }
}

__device__ __forceinline__ void ph_moe_up(const C& p, int layer) {
  const bf16_t* H = (const bf16_t*)(p.ws + WS_H);
  const int* IDX = (const int*)(p.ws + WS_IDX);
  bf16_t* HID = (bf16_t*)(p.ws + WS_HID);
  for (int t = p.vb; t < 1536; t += p.nb) {
    const int e = t / 96, rem = t % 96, m0 = (rem % 6) * 128, n0 = (rem / 6) * 64;
    const float* W1 = p.in[32] + ((size_t)layer * 16 + e) * 1024 * 1024;
    const float* W3 = p.in[33] + ((size_t)layer * 16 + e) * 1024 * 1024;
    const int myrow = IDX[e * 768 + m0 + (p.tid >> 1)];
    const bf16_t* arow = H + (size_t)myrow * DM;
    gemm_core<1, true>(p.tid, 1024,
      [=](int, int k) { return *(const uint4*)(arow + k); },
      [=](int, int k, int n) { const int seg = n >> 5; return ldg4((seg & 1) ? W3 : W1, (unsigned)(k * 1024 + n0 + (seg >> 1) * 32 + (n & 31))); },
      [=](int m, int n, const float (&v)[2][4]) {
#pragma unroll
        for (int i = 0; i < 4; ++i) {
          const float a = v[0][i];
          HID[((size_t)e * 768 + m0 + m + i) * 1024 + n0 + n] = f2bf(a / (1.f + expf(-a)) * v[1][i]);
        }
      });
  }
}

__device__ __forceinline__ void ph_moe_down(const C& p, int layer) {
  const bf16_t* HID = (const bf16_t*)(p.ws + WS_HID);
  bf16_t* YE = (bf16_t*)(p.ws + WS_YE);
  for (int t = p.vb; t < 768; t += p.nb) {
    const int e = t / 48, rem = t % 48, m0 = (rem % 6) * 128, n0 = (rem / 6) * 128;
    const float* W2 = p.in[34] + ((size_t)layer * 16 + e) * 1024 * 1024;
    const bf16_t* A = HID + ((size_t)e * 768 + m0) * 1024;
    bf16_t* Y = YE + ((size_t)e * 768 + m0) * 1024 + n0;
    gemm_tile<1>(p.tid, 1024,
      [=](int m, int k) { return *(const uint4*)(A + (size_t)m * 1024 + k); },
      [=](int, int k, int n) { return ldg4(W2, (unsigned)(k * 1024 + n0 + n)); },
      [=](int m, int n, const float (&v)[1][4]) {
#pragma unroll
        for (int i = 0; i < 4; ++i) Y[(size_t)(m + i) * 1024 + n] = f2bf(v[0][i]);
      });
  }
}

__device__ __forceinline__ void ph_gemm_in1(const C& p) {
  const bf16_t* H = (const bf16_t*)(p.ws + WS_H);
  const float* W = p.in[25];
  float* Z1 = (float*)(p.ws + WS_Z1);
  for (int t = p.vb; t < 48 * 6; t += p.nb) {
    int mt_, nt_; tile_mn(t, 48, 6, mt_, nt_);
    const int m0 = mt_ * 128, n0 = nt_ * 128;
    gemm_tile<1>(p.tid, 1024,
      [=](int m, int k) { return *(const uint4*)(H + (size_t)(m0 + m) * DM + k); },
      [=](int, int k, int n) { return (n0 + n < IN1C) ? ldg4(W, (unsigned)(k * IN1C + n0 + n)) : make_float4(0.f, 0.f, 0.f, 0.f); },
      [=](int m, int n, const float (&v)[1][4]) {
        if (n0 + n < IN1C) {
#pragma unroll
          for (int i = 0; i < 4; ++i) Z1[(size_t)(m0 + m + i) * IN1C + n0 + n] = v[0][i];
        }
      });
  }
}

__device__ __forceinline__ int kofs(int seq) { return seq < 16 ? seq * 256 : 4096 + (seq - 16) * 1280; }
__device__ __forceinline__ void keyrow_geom(int row, int& seq, int& pos, int& nk) {
  if (row < NPR) { seq = row >> 8; pos = row & 255; nk = 256; }
  else if (row < NTOK) { seq = 16 + ((row - NPR) >> 10); pos = 256 + ((row - NPR) & 1023); nk = 1280; }
  else { seq = 16 + ((row - NTOK) >> 8); pos = (row - NTOK) & 255; nk = 1280; }
}

__device__ __forceinline__ int kfrag_off(int key, int d) { return (d >> 4) * 512 + ((d >> 3) & 1) * 256 + key * 8 + (d & 7); }

__device__ __forceinline__ void ph_mla_norm(const C& p) {
  const int tid = p.tid, lane = tid & 63, wave = tid >> 6;
  const float* Z1 = (const float*)(p.ws + WS_Z1);
  const float* tab = (const float*)(p.ws + WS_ROPE);
  bf16_t* CQN = (bf16_t*)(p.ws + WS_CQN);
  bf16_t* CKVN = (bf16_t*)(p.ws + WS_CKVN);
  bf16_t* KH = (bf16_t*)(p.ws + WS_KH);
  const float* qn = p.in[26]; const float* kvn = p.in[27];
  for (int row = p.bid * 4 + wave; row < NKROW; row += p.nb * 4) {
    if (row < NTOK) {
      const float* z = Z1 + (size_t)row * IN1C;
      float cq[6], ss = 0.f;
#pragma unroll
      for (int i = 0; i < 6; ++i) { cq[i] = z[i * 64 + lane]; ss += cq[i] * cq[i]; }
      ss = wave_sum(ss, lane);
      const float rq = rsqrtf(ss * (1.f / 384.f) + RMS_EPS);
#pragma unroll
      for (int i = 0; i < 6; ++i) CQN[(size_t)row * 384 + i * 64 + lane] = f2bf(cq[i] * rq * qn[i * 64 + lane]);
      float ck[4], s2 = 0.f;
#pragma unroll
      for (int i = 0; i < 4; ++i) { ck[i] = z[384 + i * 64 + lane]; s2 += ck[i] * ck[i]; }
      s2 = wave_sum(s2, lane);
      const float rk = rsqrtf(s2 * (1.f / 256.f) + RMS_EPS);
#pragma unroll
      for (int i = 0; i < 4; ++i) {
        const float o = ck[i] * rk * kvn[i * 64 + lane];
        CKVN[(size_t)row * 256 + i * 64 + lane] = f2bf(o);
        if (row < NPR) p.out[O_CKV + (size_t)row * 256 + i * 64 + lane] = o;
      }
      float kp = z[640 + lane];
      if (row < NPR) {
        p.out[O_KPE + (size_t)row * 64 + lane] = kp;
      } else {
        const int tt = (row - NPR) & 1023;
        const int grp = lane >> 5, idx = lane & 31, f = idx & 15;
        const int pos = grp ? (tt & 63) : (tt >> 6);
        const float cs = tab[(pos * 16 + f) * 2], sn = tab[(pos * 16 + f) * 2 + 1];
        const float pr = swz<16>(kp);
        kp = (idx < 16) ? (kp * cs - pr * sn) : (pr * sn + kp * cs);
      }
      { int seq, pos, nk; keyrow_geom(row, seq, pos, nk);
        const bf16_t kb = f2bf(kp);
#pragma unroll
        for (int hh = 0; hh < 8; ++hh) KH[((size_t)kofs(seq) * 8 + (size_t)hh * nk + (pos & ~31)) * 192 + kfrag_off(pos & 31, 128 + lane)] = kb; }
    } else {
      const int cr = row - NTOK;
      const float* c = p.in[3] + (size_t)cr * 256;
#pragma unroll
      for (int i = 0; i < 4; ++i) CKVN[(size_t)row * 256 + i * 64 + lane] = f2bf(c[i * 64 + lane]);
      { int seq, pos, nk; keyrow_geom(row, seq, pos, nk);
        const bf16_t kb = f2bf(p.in[4][(size_t)cr * 64 + lane]);
#pragma unroll
        for (int hh = 0; hh < 8; ++hh) KH[((size_t)kofs(seq) * 8 + (size_t)hh * nk + (pos & ~31)) * 192 + kfrag_off(pos & 31, 128 + lane)] = kb; }
    }
  }
}

__device__ __forceinline__ void ph_mla_qkv(const C& p) {
  const bf16_t* CQN = (const bf16_t*)(p.ws + WS_CQN);
  const bf16_t* CKVN = (const bf16_t*)(p.ws + WS_CKVN);
  const float* tab = (const float*)(p.ws + WS_ROPE);
  bf16_t* QB = (bf16_t*)(p.ws + WS_QBUF);
  bf16_t* KH = (bf16_t*)(p.ws + WS_KH);
  bf16_t* VT = (bf16_t*)(p.ws + WS_VT);
  const float* Wq = p.in[28]; const float* Wkv = p.in[29];
  for (int t = p.vb; t < 576 + 832; t += p.nb) {
    if (t < 576) {
      int mt_, nt_; tile_mn(t, 48, 12, mt_, nt_);
      const int m0 = mt_ * 128, n0 = nt_ * 128;
      gemm_tile<1>(p.tid, 384,
        [=](int m, int k) { return *(const uint4*)(CQN + (size_t)(m0 + m) * 384 + k); },
        [=](int, int k, int n) { return ldg4(Wq, (unsigned)(k * 1536 + n0 + n)); },
        [=](int m, int n, const float (&v)[1][4]) {
          const int nn = n0 + n;
          const int sub = (nn % 192) >> 5;
          float o[4] = {v[0][0], v[0][1], v[0][2], v[0][3]};
          if (m0 >= NPR && sub >= 4) {
            const int idx = nn & 31, f = idx & 15;
#pragma unroll
            for (int i = 0; i < 4; ++i) {
              const int tt = (m0 + m + i - NPR) & 1023;
              const int pos = (sub == 5) ? (tt & 63) : (tt >> 6);
              const float cs = tab[(pos * 16 + f) * 2], sn = tab[(pos * 16 + f) * 2 + 1];
              const float pr = swz<16>(o[i]);
              o[i] = (idx < 16) ? (o[i] * cs - pr * sn) : (pr * sn + o[i] * cs);
            }
          }
#pragma unroll
          for (int i = 0; i < 4; ++i) QB[(size_t)(m0 + m + i) * 1536 + nn] = f2bf(o[i]);
        });
    } else {
      const int t2 = t - 576;
      int mt_, nt_; tile_mn(t2, 52, 16, mt_, nt_);
      const int m0 = mt_ * 128, n0 = nt_ * 128;
      int seq, pos0, nk; keyrow_geom(m0, seq, pos0, nk);
      const int h = n0 >> 8;
      const bool isv = (n0 & 128) != 0;
      bf16_t* kdst0 = KH + ((size_t)kofs(seq) * 8 + (size_t)h * nk) * 192;
      bf16_t* vdst = VT + ((size_t)kofs(seq) * 8 + (size_t)h * nk) * 128;
      auto alkv = [=](int m, int k) { return *(const uint4*)(CKVN + (size_t)(m0 + m) * 256 + k); };
      auto blkv = [=](int, int k, int n) { return ldg4(Wkv, (unsigned)(k * 2048 + n0 + n)); };
      if (!isv) {
        gemm_tile<1>(p.tid, 256, alkv, blkv,
          [=](int m, int n, const float (&v)[1][4]) {
#pragma unroll
            for (int i = 0; i < 4; ++i) { const int pp = pos0 + m + i; kdst0[(size_t)(pp & ~31) * 192 + kfrag_off(pp & 31, n)] = f2bf(v[0][i]); }
          });
      } else {
        gemm_tile<1>(p.tid, 256, alkv, blkv,
          [=](int m, int n, const float (&v)[1][4]) {
            const int pos = pos0 + m;
            uint2 w; w.x = pk2(v[0][0], v[0][1]); w.y = pk2(v[0][2], v[0][3]);
            const int kk = pos & 31;
            *(uint2*)(vdst + (size_t)(pos >> 5) * 4096 + (((n >> 5) * 2 + (kk >> 4)) * 2 + ((kk >> 2) & 1)) * 256 + (n & 31) * 8 + ((kk >> 3) & 1) * 4) = w;
          });
      }
    }
  }
}

__device__ __forceinline__ void attn_item(const C& p, int seq, int hd, int qtok0, int tid) {
  const int lane = tid & 63, wave = tid >> 6, l31 = lane & 31, lh = lane >> 5;
  const bf16_t* QB = (const bf16_t*)(p.ws + WS_QBUF);
  const bf16_t* KH = (const bf16_t*)(p.ws + WS_KH);
  const bf16_t* VT = (const bf16_t*)(p.ws + WS_VT);
  bf16_t* OUT = (bf16_t*)(p.ws + WS_YCAT);
  float* Oacc = (float*)smem;
  float* sm_m = Oacc + 8192;
  float* sm_l = sm_m + 128;
  const int qt = wave & 1, khf = wave >> 1;
  const int nk = seq < 16 ? 256 : 1280;
  const int ntile = nk >> 5, tpw = ntile >> 1;
  const bf16_t* vt = VT + ((size_t)kofs(seq) * 8 + (size_t)hd * nk) * 128;
  const bf16_t* kh = KH + ((size_t)kofs(seq) * 8 + (size_t)hd * nk) * 192;
  bf16_t* Qs = (bf16_t*)(sm_l + 128);
#pragma unroll
  for (int i = 0; i < 6; ++i) {
    const int idx = tid + i * 256, row = idx / 24, c8 = (idx % 24) * 8;
    *(uint4*)&Qs[row * 200 + c8] = *(const uint4*)(QB + (size_t)(qtok0 + row) * 1536 + hd * 192 + c8);
  }
  __syncthreads();
  const bf16_t* qs = Qs + (qt * 32 + l31) * 200 + lh * 8;
  f32x16 oacc[4];
#pragma unroll
  for (int dt = 0; dt < 4; ++dt)
#pragma unroll
    for (int r = 0; r < 16; ++r) oacc[dt][r] = 0.f;
  float mrun = -1e30f, lrun = 0.f;
#pragma unroll 1
  for (int kt = khf * tpw; kt < (khf + 1) * tpw; ++kt) {
    bf16x8 kf[12]; uint4 vf[8];
    const bf16_t* kn = kh + (size_t)kt * 6144 + lh * 256 + l31 * 8;
#pragma unroll
    for (int ks = 0; ks < 12; ++ks) kf[ks] = *(const bf16x8*)(kn + ks * 512);
    const bf16_t* vp = vt + (size_t)kt * 4096 + lh * 256 + l31 * 8;
#pragma unroll
    for (int dt = 0; dt < 4; ++dt) {
      vf[dt * 2] = *(const uint4*)(vp + (dt * 2 + 0) * 512); vf[dt * 2 + 1] = *(const uint4*)(vp + (dt * 2 + 1) * 512);
    }
    __builtin_amdgcn_sched_barrier(0);
    f32x16 s;
#pragma unroll
    for (int r = 0; r < 16; ++r) s[r] = 0.f;
#pragma unroll
    for (int ks = 0; ks < 12; ++ks) s = __builtin_amdgcn_mfma_f32_32x32x16_bf16(kf[ks], *(const bf16x8*)(qs + ks * 16), s, 0, 0, 0);
    float tmax = -1e30f;
#pragma unroll
    for (int r = 0; r < 16; ++r) { s[r] *= ATTN_SCALE; tmax = fmaxf(tmax, s[r]); }
    tmax = fmaxf(tmax, shx32(tmax, lane));
    const float mnew = fmaxf(mrun, tmax);
    const float alpha = expf(mrun - mnew);
    float ps = 0.f;
#pragma unroll
    for (int r = 0; r < 16; ++r) { s[r] = expf(s[r] - mnew); ps += s[r]; }
    ps += shx32(ps, lane);
    lrun = lrun * alpha + ps; mrun = mnew;
#pragma unroll
    for (int dt = 0; dt < 4; ++dt)
#pragma unroll
      for (int r = 0; r < 16; ++r) oacc[dt][r] *= alpha;
#pragma unroll
    for (int sh = 0; sh < 2; ++sh) {
      uint4 pw;
      pw.x = pk2(s[sh * 8 + 0], s[sh * 8 + 1]); pw.y = pk2(s[sh * 8 + 2], s[sh * 8 + 3]);
      pw.z = pk2(s[sh * 8 + 4], s[sh * 8 + 5]); pw.w = pk2(s[sh * 8 + 6], s[sh * 8 + 7]);
      const bf16x8 pf = __builtin_bit_cast(bf16x8, pw);
#pragma unroll
      for (int dt = 0; dt < 4; ++dt)
        oacc[dt] = __builtin_amdgcn_mfma_f32_32x32x16_bf16(__builtin_bit_cast(bf16x8, vf[dt * 2 + sh]), pf, oacc[dt], 0, 0, 0);
    }
  }
  for (int i = tid; i < 8192; i += 256) Oacc[i] = 0.f;
  if (lh == 0) { sm_m[wave * 32 + l31] = mrun; sm_l[wave * 32 + l31] = lrun; }
  __syncthreads();
  {
    const float m0 = sm_m[qt * 32 + l31], m1 = sm_m[(qt + 2) * 32 + l31];
    const float M = fmaxf(m0, m1);
    const float L = sm_l[qt * 32 + l31] * expf(m0 - M) + sm_l[(qt + 2) * 32 + l31] * expf(m1 - M);
    const float f = expf(mrun - M) / L;
    float* oq = Oacc + qt * 4096;
#pragma unroll
    for (int dt = 0; dt < 4; ++dt)
#pragma unroll
      for (int r = 0; r < 16; ++r) {
        const int d = dt * 32 + (r & 3) + 8 * (r >> 2) + 4 * lh;
        atomicAdd(&oq[d * 32 + l31], oacc[dt][r] * f);
      }
  }
  __syncthreads();
  {
    const int q = tid >> 2, dc = (tid & 3) * 32;
    const float* oq = Oacc + (q >> 5) * 4096 + (q & 31);
    bf16_t* dst = OUT + (size_t)(qtok0 + q) * DM + hd * 128 + dc;
#pragma unroll
    for (int h4 = 0; h4 < 4; ++h4) {
      float o[8];
#pragma unroll
      for (int i = 0; i < 8; ++i) o[i] = oq[(dc + h4 * 8 + i) * 32];
      uint4 w; w.x = pk2(o[0], o[1]); w.y = pk2(o[2], o[3]); w.z = pk2(o[4], o[5]); w.w = pk2(o[6], o[7]);
      *(uint4*)(dst + h4 * 8) = w;
    }
  }
  __syncthreads();
}
__device__ __forceinline__ void ph_attn(const C& p) {
  const int tid = p.tid;
  const int half = p.nb >> 1;
  if ((p.vb & 1) == 0) {
    for (int s_ = p.vb >> 1; s_ < 256; s_ += half) {
      const int b = s_ >> 7, hd = (s_ >> 4) & 7;
      attn_item(p, 16 + b, hd, NPR + b * 1024 + (s_ & 15) * 64, tid);
    }
  } else {
    for (int j = p.vb >> 1; j < 256; j += half) {
      for (int u = 0; u < 2; ++u) {
        const int i2 = j * 2 + u;
        const int b = i2 >> 5, hd = (i2 >> 2) & 7;
        attn_item(p, b, hd, b * 256 + (i2 & 3) * 64, tid);
      }
    }
  }
}

__device__ __forceinline__ void ph_final(const C& p) {
  const int tid = p.tid, lane = tid & 63, wave = tid >> 6;
  const float* X = (const float*)(p.ws + WS_XCUR);
  const float* g = p.in[35];
  for (int tok = p.bid * 4 + wave; tok < NTOK; tok += p.nb * 4) {
    const float* x = X + (size_t)tok * DM;
    float4 xv[4]; float ss = 0.f;
#pragma unroll
    for (int i = 0; i < 4; ++i) xv[i] = *(const float4*)(x + (i * 64 + lane) * 4);
    moe_combine_row(p, tok, 1, lane, xv);
#pragma unroll
    for (int i = 0; i < 4; ++i) ss += xv[i].x * xv[i].x + xv[i].y * xv[i].y + xv[i].z * xv[i].z + xv[i].w * xv[i].w;
    ss = wave_sum(ss, lane);
    const float rinv = rsqrtf(ss * (1.f / 1024.f) + RMS_EPS);
#pragma unroll
    for (int i = 0; i < 4; ++i) {
      const int d = (i * 64 + lane) * 4;
      const float4 gv = *(const float4*)(g + d);
      *(float4*)(p.out + O_Y + (size_t)tok * DM + d) = make_float4(xv[i].x * rinv * gv.x, xv[i].y * rinv * gv.y, xv[i].z * rinv * gv.z, xv[i].w * rinv * gv.w);
    }
  }
}

#define NPHASE 24
__device__ __forceinline__ void run_phase(const C& p, int ph) {
  switch (ph) {
    case 0: ph_ada(p); break;
    case 1: case 13: { const int L = ph == 13; ph_prep<false>(p, !L, p.in[9] + L * 1024, L, 0, nullptr); } break;
    case 2: ph_gemm_in0(p); break;
    case 3: ph_mix(p); break;
    case 4: ph_lora(p); break;
    case 5: ph_scan(p); break;
    case 6: ph_scanfix(p); break;
    case 7: ph_post(p); break;
    case 8: case 18: { const int L = ph == 18; ph_gemm_out(p, L ? p.in[30] : p.in[24], L, !L); } break;
    case 9: case 19: { const int L = ph == 19; ph_router(p, p.in[10] + L * 1024, L, p.in[31] + L * 1024 * 16); } break;
    case 10: case 20: ph_topk(p); break;
    case 11: case 21: ph_moe_up(p, ph == 21); break;
    case 12: case 22: ph_moe_down(p, ph == 22); break;
    case 14: ph_gemm_in1(p); break;
    case 15: ph_mla_norm(p); break;
    case 16: ph_mla_qkv(p); break;
    case 17: ph_attn(p); break;
    case 23: ph_final(p); break;
    default: break;
  }
}

__global__ void __launch_bounds__(256, 2) fwd_kernel(P p) {
  if (threadIdx.x == 0) xb_words = make_uint4(0u, 0u, 0u, 0u);
  __syncthreads();
  XcdBarrier bar = xcd_barrier_post((unsigned*)(p.ws + WS_BAR), (volatile LAS unsigned*)&xb_words);
  C c; (P&)c = p; c.nb = gridDim.x;
  const int wv_ = __builtin_amdgcn_readfirstlane(threadIdx.x >> 6);
#ifdef ONLY_PHASE
  c.tid = wv_ * 64 + (int)__builtin_amdgcn_mbcnt_hi(~0u, __builtin_amdgcn_mbcnt_lo(~0u, 0u)); c.bid = blockIdx.x; c.vb = (c.bid & 7) * (c.nb >> 3) + (c.bid >> 3);
  run_phase(c, ONLY_PHASE); xcd_barrier(bar);
#else
  for (int ph = p.ph_lo; ph < p.ph_hi; ++ph) {
    const int reps = (ph == p.probe_ph) ? p.probe_reps : 1;
    for (int r = 0; r < reps; ++r) {
      if (r) __syncthreads();
      int l_; asm volatile("v_mbcnt_lo_u32_b32 %0, -1, 0\n\tv_mbcnt_hi_u32_b32 %0, -1, %0" : "=v"(l_));
      int t_ = wv_ * 64 + l_, b_ = blockIdx.x; unsigned char* w_ = p.ws;
      asm volatile("" : "+v"(t_)); asm volatile("" : "+s"(b_)); asm volatile("" : "+s"(w_));
      c.tid = t_; c.bid = b_; c.ws = w_; c.vb = (b_ & 7) * (c.nb >> 3) + (b_ >> 3);
      run_phase(c, ph);
    }
    if (ph + 1 < p.ph_hi) xcd_barrier(bar);
  }
#endif
}

extern "C" void kernel_launch(void* const* d_in, const int* in_sizes, int n_in, void* d_out, int out_size, void* d_ws, size_t ws_size, hipStream_t stream) {
  static int grid = 0;
  if (grid == 0) {
    int dev = 0, cus = 0, per_cu = 0;
    hipGetDevice(&dev);
    hipDeviceGetAttribute(&cus, hipDeviceAttributeMultiprocessorCount, dev);
    hipOccupancyMaxActiveBlocksPerMultiprocessor(&per_cu, (const void*)fwd_kernel, 256, 0);
    (void)hipGetLastError();
    if (per_cu < 1) per_cu = 1;
    if (per_cu > 2) per_cu = 2;
    grid = cus * per_cu;
    grid &= ~7;
    if (grid < 8) grid = 8;
    if (ws_size < WS_END0) fprintf(stderr, "kernel_launch: workspace too small (%zu < %llu)\n", ws_size, (unsigned long long)WS_END0);
  }
  hipMemsetAsync((char*)d_ws + WS_BAR, 0, XCD_BAR_WORDS * 4, stream);
  P p{};
  for (int i = 0; i < 36; ++i) p.in[i] = (const float*)d_in[i];
  p.out = (float*)d_out; p.ws = (unsigned char*)d_ws;
  p.probe_ph = -1; p.probe_reps = 1;
#ifdef MULTI_LAUNCH
  for (int ph = 0; ph < NPHASE; ++ph) {
    p.ph_lo = ph; p.ph_hi = ph + 1;
    hipLaunchKernelGGL(fwd_kernel, dim3(grid), dim3(256), 0, stream, p);
  }
#else
  p.ph_lo = 0; p.ph_hi = NPHASE;
  hipLaunchKernelGGL(fwd_kernel, dim3(grid), dim3(256), 0, stream, p);
#endif
}
```

```cpp
#include <hip/hip_runtime.h>
#include <stdint.h>
#include <stdio.h>

typedef __attribute__((ext_vector_type(8))) short bf16x8;
typedef __attribute__((ext_vector_type(16))) float f32x16;
typedef unsigned short bf16_t;
typedef const __attribute__((address_space(4))) float cflt;
#define LAS __attribute__((address_space(3)))

#define NTOK 6144
#define NPR 4096
#define NSA 2048
#define DM 1024
#define IN0C 3456
#define ZMC 1920
#define IN1C 704
#define NKROW 6656
#define DECAY_SCALE 0.606531f
#define GN_EPS 64e-5f
#define RMS_EPS 1e-6f
#define ATTN_SCALE 0.07216878364870322f

#define WS_BAR   0ull
#define WS_MOD   (64ull << 10)
#define WS_ROPE  (WS_MOD + (256ull << 10))
#define WS_AFF   (WS_ROPE + (64ull << 10))
#define WS_IDX   (WS_AFF + (512ull << 10))
#define WS_GATE  (WS_IDX + (64ull << 10))
#define WS_H     (1ull << 20)
#define WS_YCAT  (WS_H + 12582912ull)
#define WS_XCUR  (WS_YCAT + 12582912ull)
#define WS_HID   (WS_XCUR + 25165824ull)
#define WS_Z     (WS_HID + 25165824ull)
#define WS_ZM    (WS_Z + 84934656ull)
#define WS_OPSA  (WS_ZM + 47185920ull)
#define WS_OPSB  (WS_OPSA + 25165824ull)
#define WS_GG    (WS_OPSB + 75497472ull)
#define WS_YD    (WS_GG + 12582912ull)
#define WS_UD    (WS_YD + 25165824ull)
#define WS_PQ    (WS_UD + 25165824ull)
#define WS_SEL   (WS_PQ + 25165824ull)
#define WS_END0  (WS_SEL + 393216ull)
#define WS_YE    WS_ZM
#define WS_Z1    WS_Z
#define WS_CQN   (WS_Z1 + 17301504ull)
#define WS_CKVN  (WS_CQN + 4718592ull)
#define WS_KPE   (WS_CKVN + 3407872ull)
#define WS_QBUF  (WS_KPE + 851968ull)
#define WS_KH    (WS_QBUF + 18874368ull)
#define WS_VT    (WS_KH + 20447232ull)

#define O_Y    0
#define O_ST   6291456
#define O_CKV  7340032
#define O_KPE  8388608

struct P {
  const float* in[36];
  float* out;
  unsigned char* ws;
  int ph_lo, ph_hi;
  int probe_ph, probe_reps;
};

struct C : P { int tid, bid, nb, vb; };

#define SMEM_BYTES 61440
__shared__ __attribute__((aligned(16))) unsigned char smem[SMEM_BYTES];
__shared__ uint4 xb_words;

__device__ __forceinline__ unsigned pk2(float lo, float hi) {
  typedef __attribute__((ext_vector_type(2))) __bf16 bf2;
  typedef __attribute__((ext_vector_type(2))) float fl2;
  fl2 f = {lo, hi};
  bf2 b = __builtin_convertvector(f, bf2);
  return __builtin_bit_cast(unsigned, b);
}
__device__ __forceinline__ bf16_t f2bf(float f) { return (bf16_t)(pk2(f, 0.f) & 0xffffu); }
__device__ __forceinline__ float bf2f(bf16_t b) { return __uint_as_float(((unsigned)b) << 16); }
__device__ __forceinline__ float sigmoidf_(float x) { return 1.f / (1.f + expf(-x)); }
__device__ __forceinline__ float fsigmoid_(float x) { return __builtin_amdgcn_rcpf(1.f + __builtin_amdgcn_exp2f(-1.4426950408889634f * x)); }
__device__ __forceinline__ float ftanh_(float x) { return 1.f - 2.f * __builtin_amdgcn_rcpf(1.f + __builtin_amdgcn_exp2f(2.8853900817779268f * x)); }
template <int M> __device__ __forceinline__ float swz(float v) {
  return __builtin_bit_cast(float, __builtin_amdgcn_ds_swizzle(__builtin_bit_cast(int, v), (M << 10) | 0x1f));
}
__device__ __forceinline__ float shx32(float v, int lane) {
  return __builtin_bit_cast(float, __builtin_amdgcn_ds_bpermute((lane ^ 32) << 2, __builtin_bit_cast(int, v)));
}
__device__ __forceinline__ float wave_sum(float v, int lane) {
  v += swz<1>(v); v += swz<2>(v); v += swz<4>(v); v += swz<8>(v); v += swz<16>(v); v += shx32(v, lane);
  return v;
}
__device__ __forceinline__ float4 ldg4(const float* base, unsigned off) { return *(const float4*)((const char*)base + (size_t)(off * 4u)); }
__device__ __forceinline__ int modrow(int tok) { return tok < NPR ? 0 : 1 + ((tok - NPR) >> 10); }

#define XB_TMO      128
#define XB_XCNT(j)  (256  + 64 * (j))
#define XB_XSUB(j)  (1280 + 64 * (j))
#define XB_XGEN(j)  (2304 + 64 * (j))
#define XB_TOP      3328
#define XB_TOPGEN   3392
#define XCD_BAR_WORDS 3456
#define XB_SPIN_CAP (1u << 20)
__device__ __forceinline__ unsigned xb_ld(unsigned* p)              { return __hip_atomic_load(p, __ATOMIC_RELAXED, __HIP_MEMORY_SCOPE_AGENT); }
__device__ __forceinline__ unsigned xb_add(unsigned* p, unsigned v) { return __hip_atomic_fetch_add(p, v, __ATOMIC_RELAXED, __HIP_MEMORY_SCOPE_AGENT); }
__device__ __forceinline__ unsigned xb_xcc_id() { return (unsigned)__builtin_amdgcn_s_getreg((3 << 11) | 20) & 0xFu; }
#define XB_SPIN(cond, bar) do { unsigned _sp = 0; while (cond) { __builtin_amdgcn_s_sleep(1); \
    if ((++_sp & 255u) == 0u) { if (xb_ld(&(bar)[XB_TMO])) break; if (_sp > XB_SPIN_CAP) { atomicAdd(&(bar)[XB_TMO], 1u); break; } } } } while (0)
struct XcdBarrier { unsigned* bar; unsigned x; volatile LAS unsigned* st; };
__device__ __forceinline__ XcdBarrier xcd_barrier_post(unsigned* bar, volatile LAS unsigned* st) {
  XcdBarrier b; b.bar = bar; b.x = xb_xcc_id(); b.st = st;
  if (threadIdx.x == 0) (void)xb_add(&bar[XB_XCNT(b.x)], 1u);
  return b;
}
__device__ __forceinline__ void xcd_barrier_complete(unsigned* bar, unsigned x, unsigned& nloc, unsigned& nx) {
  const unsigned G = gridDim.x * gridDim.y * gridDim.z;
  unsigned sum, cnt, mine, sp = 0u;
  for (;;) {
    sum = 0u; cnt = 0u; mine = 0u;
#pragma unroll
    for (unsigned j = 0; j < 16; ++j) { const unsigned c = xb_ld(&bar[XB_XCNT(j)]); sum += c; cnt += (c > 0u) ? 1u : 0u; mine = (j == x) ? c : mine; }
    if (sum == G) break;
    __builtin_amdgcn_s_sleep(1);
    if ((++sp & 255u) == 0u) { if (xb_ld(&bar[XB_TMO])) break; if (sp > XB_SPIN_CAP) { atomicAdd(&bar[XB_TMO], 1u); break; } }
  }
  nloc = mine > 0u ? mine : 1u; nx = cnt > 0u ? cnt : 1u;
}
__device__ __forceinline__ void xcd_barrier(const XcdBarrier& b) {
  asm volatile("s_waitcnt vmcnt(0)" ::: "memory");
  __syncthreads();
  if (threadIdx.x == 0) {
    unsigned* bar = b.bar;
    __builtin_amdgcn_s_waitcnt(0);
    unsigned nloc = b.st[0], nx = b.st[1];
    if (nloc == 0u) { xcd_barrier_complete(bar, b.x, nloc, nx); b.st[0] = nloc; b.st[1] = nx; }
    const unsigned old = xb_add(&bar[XB_XSUB(b.x)], 1u);
    const unsigned gen = old / nloc;
    if (old + 1u == (gen + 1u) * nloc) {
      __builtin_amdgcn_fence(__ATOMIC_RELEASE, "agent");
      asm volatile("s_waitcnt vmcnt(0)" ::: "memory");
      const unsigned og = xb_add(&bar[XB_TOP], 1u);
      const unsigned tg = og / nx;
      if (og + 1u == (tg + 1u) * nx) xb_add(&bar[XB_TOPGEN], 1u);
      else XB_SPIN(xb_ld(&bar[XB_TOPGEN]) == tg, bar);
      __builtin_amdgcn_fence(__ATOMIC_ACQUIRE, "agent");
      xb_add(&bar[XB_XGEN(b.x)], 1u);
      asm volatile("s_waitcnt vmcnt(0)" ::: "memory");
    } else {
      XB_SPIN(xb_ld(&bar[XB_XGEN(b.x)]) == gen, bar);
      __builtin_amdgcn_fence(__ATOMIC_ACQUIRE, "agent");
      asm volatile("s_waitcnt vmcnt(0)" ::: "memory");
    }
  }
  __syncthreads();
}

#define LDS_S 72
template <int NB, bool PAIR, class AL, class BL, class EP>
__device__ __forceinline__ void gemm_core(int tid_, int K, AL al, BL bl, EP ep) {
  bf16_t* As = (bf16_t*)smem;
  bf16_t* Bs = As + 128 * LDS_S;
  const int tid = tid_, lane = tid & 63, wave = tid >> 6;
  const int wm = wave >> 1, wn = wave & 1, l31 = lane & 31, lh = lane >> 5;
  f32x16 acc[NB][2][2];
#pragma unroll
  for (int b = 0; b < NB; ++b)
#pragma unroll
    for (int i = 0; i < 2; ++i)
#pragma unroll
      for (int j = 0; j < 2; ++j)
#pragma unroll
        for (int r = 0; r < 16; ++r) acc[b][i][j][r] = 0.f;
  const int arow = tid >> 1, akb = (tid & 1) * 32;
  const int bng = (tid & 31) * 4, bkg = (tid >> 5) * 8;
  uint4 ra[4]; float4 rb[2][8];
#pragma unroll
  for (int i = 0; i < 4; ++i) ra[i] = al(arow, akb + i * 8);
#pragma unroll
  for (int i = 0; i < 8; ++i) rb[0][i] = bl(0, bkg + i, bng);
  if (K > 64) {
#pragma unroll
    for (int i = 0; i < 8; ++i) rb[1][i] = bl(0, 64 + bkg + i, bng);
  }
#pragma unroll 1
  for (int kbase = 0; kbase < K; kbase += 128) {
#pragma unroll
  for (int hb = 0; hb < 2; ++hb) {
    const int k0 = kbase + hb * 64;
    if (k0 < K) {
#pragma unroll
    for (int i = 0; i < 4; ++i) *(uint4*)&As[arow * LDS_S + akb + i * 8] = ra[i];
#pragma unroll
    for (int j = 0; j < 4; ++j) {
      uint4 w;
      w.x = pk2(((const float*)&rb[hb][0])[j], ((const float*)&rb[hb][1])[j]);
      w.y = pk2(((const float*)&rb[hb][2])[j], ((const float*)&rb[hb][3])[j]);
      w.z = pk2(((const float*)&rb[hb][4])[j], ((const float*)&rb[hb][5])[j]);
      w.w = pk2(((const float*)&rb[hb][6])[j], ((const float*)&rb[hb][7])[j]);
      *(uint4*)&Bs[(bng + j) * LDS_S + bkg] = w;
    }
    __syncthreads();
    if (k0 + 64 < K) {
#pragma unroll
      for (int i = 0; i < 4; ++i) ra[i] = al(arow, k0 + 64 + akb + i * 8);
    }
    if (k0 + 128 < K) {
#pragma unroll
      for (int i = 0; i < 8; ++i) rb[hb][i] = bl(0, k0 + 128 + bkg + i, bng);
    }
#pragma unroll
    for (int ks = 0; ks < 4; ++ks) {
      bf16x8 af[2], bfr[2];
#pragma unroll
      for (int mt = 0; mt < 2; ++mt) af[mt] = *(const bf16x8*)&As[(wm * 64 + mt * 32 + l31) * LDS_S + ks * 16 + lh * 8];
#pragma unroll
      for (int nt = 0; nt < 2; ++nt) bfr[nt] = *(const bf16x8*)&Bs[(wn * 64 + nt * 32 + l31) * LDS_S + ks * 16 + lh * 8];
#pragma unroll
      for (int mt = 0; mt < 2; ++mt)
#pragma unroll
        for (int nt = 0; nt < 2; ++nt) acc[0][mt][nt] = __builtin_amdgcn_mfma_f32_32x32x16_bf16(af[mt], bfr[nt], acc[0][mt][nt], 0, 0, 0);
    }
    __syncthreads();
    }
  }
  }
  int eM = wm * 64 + lh * 4, eN = l31;
  asm volatile("" : "+v"(eM), "+v"(eN));
  if constexpr (PAIR) {
#pragma unroll
    for (int mt = 0; mt < 2; ++mt)
#pragma unroll
      for (int rg = 0; rg < 4; ++rg) {
        float v[2][4];
#pragma unroll
        for (int i = 0; i < 4; ++i) { v[0][i] = acc[0][mt][0][rg * 4 + i]; v[1][i] = acc[0][mt][1][rg * 4 + i]; }
        ep(eM + mt * 32 + rg * 8, wn * 32 + eN, v);
      }
  } else {
#pragma unroll
    for (int mt = 0; mt < 2; ++mt)
#pragma unroll
      for (int nt = 0; nt < 2; ++nt)
#pragma unroll
        for (int rg = 0; rg < 4; ++rg) {
          float v[NB][4];
#pragma unroll
          for (int b = 0; b < NB; ++b)
#pragma unroll
            for (int i = 0; i < 4; ++i) v[b][i] = acc[b][mt][nt][rg * 4 + i];
          ep(eM + mt * 32 + rg * 8, wn * 64 + nt * 32 + eN, v);
        }
  }
}
template <int NB, class AL, class BL, class EP>
__device__ __forceinline__ void gemm_tile(int tid_, int K, AL al, BL bl, EP ep) { gemm_core<NB, false>(tid_, K, al, bl, ep); }

__device__ __forceinline__ void tile_mn(int T, int Mt, int Nt, int& mt, int& nt) {
  const int g = T / (Mt * 4), rem = T - g * Mt * 4;
  const int gs = (Nt - 4 * g) < 4 ? (Nt - 4 * g) : 4;
  mt = rem / gs; nt = 4 * g + rem % gs;
}

__device__ __forceinline__ void ph_ada(const C& p) {
  const int tid = p.tid;
  float* sc = (float*)smem;
  float* red = sc + 3072;
  const float* cc = p.in[5]; const float* cctx = p.in[6];
  for (int i = tid; i < 3072; i += 256) {
    int r = i >> 10, k = i & 1023;
    float c = (r == 0) ? cctx[k] : cc[(r - 1) * 1024 + k];
    sc[i] = c / (1.f + expf(-c));
  }
  __syncthreads();
  float* mod = (float*)(p.ws + WS_MOD);
  for (int t = p.bid; t < 384; t += p.nb) {
    const int layer = t / 192, c0 = (t % 192) * 32;
    const int cg = tid & 7, kg = tid >> 3;
    const float* W = p.in[7] + (size_t)layer * 1024 * 6144 + c0 + cg * 4;
    float a[3][4];
#pragma unroll
    for (int r = 0; r < 3; ++r)
#pragma unroll
      for (int j = 0; j < 4; ++j) a[r][j] = 0.f;
#pragma unroll 8
    for (int kk = 0; kk < 32; ++kk) {
      const int k = kg * 32 + kk;
      const float4 w = *(const float4*)(W + (size_t)k * 6144);
#pragma unroll
      for (int r = 0; r < 3; ++r) {
        const float s = sc[r * 1024 + k];
        a[r][0] += s * w.x; a[r][1] += s * w.y; a[r][2] += s * w.z; a[r][3] += s * w.w;
      }
    }
#pragma unroll
    for (int r = 0; r < 3; ++r)
#pragma unroll
      for (int j = 0; j < 4; ++j) red[(kg * 3 + r) * 32 + cg * 4 + j] = a[r][j];
    __syncthreads();
    if (tid < 96) {
      const int r = tid >> 5, c = tid & 31;
      float s = 0.f;
#pragma unroll
      for (int g = 0; g < 32; ++g) s += red[(g * 3 + r) * 32 + c];
      mod[(size_t)(layer * 3 + r) * 6144 + c0 + c] = s + p.in[8][layer * 6144 + c0 + c];
    }
    __syncthreads();
  }
  if (p.bid == p.nb - 1) {
    float* tab = (float*)(p.ws + WS_ROPE);
    for (int i = tid; i < 1024; i += 256) {
      const int pos = i >> 4, f = i & 15;
      const float ang = (float)pos * powf(10000.f, -(float)f / 16.f);
      tab[i * 2] = cosf(ang); tab[i * 2 + 1] = sinf(ang);
    }
  }
}

__device__ __forceinline__ void moe_combine_row(const C& p, int tok, int ml, int lane, float4 (&xv)[4]) {
  const int* SEL = (const int*)(p.ws + WS_SEL);
  const float* aff = (const float*)(p.ws + WS_AFF);
  const float* mod = (const float*)(p.ws + WS_MOD);
  const bf16_t* YE = (const bf16_t*)(p.ws + WS_YE);
  const int grp = tok >= NPR, nloc = tok - grp * NPR;
  float4 acc[4];
#pragma unroll
  for (int i = 0; i < 4; ++i) acc[i] = make_float4(0.f, 0.f, 0.f, 0.f);
  int sl[16]; float gts[16];
#pragma unroll
  for (int q = 0; q < 4; ++q) { const int4 v = *(const int4*)(SEL + tok * 16 + q * 4); sl[q * 4] = v.x; sl[q * 4 + 1] = v.y; sl[q * 4 + 2] = v.z; sl[q * 4 + 3] = v.w; }
#pragma unroll
  for (int e = 0; e < 16; ++e) gts[e] = aff[(size_t)(grp * 16 + e) * 4096 + nloc];
#pragma unroll
  for (int e = 0; e < 16; ++e) {
    const int slot = sl[e];
    if (slot >= 0) {
      const float gt = gts[e];
      const bf16_t* ye = YE + (size_t)(e * 768 + slot) * 1024;
#pragma unroll
      for (int i = 0; i < 4; ++i) {
        const uint2 w = *(const uint2*)(ye + (i * 64 + lane) * 4);
        acc[i].x += gt * __uint_as_float(w.x << 16); acc[i].y += gt * __uint_as_float(w.x & 0xffff0000u);
        acc[i].z += gt * __uint_as_float(w.y << 16); acc[i].w += gt * __uint_as_float(w.y & 0xffff0000u);
      }
    }
  }
  const float* g5 = mod + (size_t)(ml * 3 + modrow(tok)) * 6144 + 5 * 1024;
#pragma unroll
  for (int i = 0; i < 4; ++i) {
    const float4 gv = *(const float4*)(g5 + (i * 64 + lane) * 4);
    xv[i].x += gv.x * acc[i].x; xv[i].y += gv.y * acc[i].y; xv[i].z += gv.z * acc[i].z; xv[i].w += gv.w * acc[i].w;
  }
}

template <bool ROUTER>
__device__ __forceinline__ void ph_prep(const C& p, bool from_inputs, const float* g, int layer, int slot_shift, const float* rw) {
  const int tid = p.tid, lane = tid & 63, wave = tid >> 6;
  const float* mod = (const float*)(p.ws + WS_MOD);
  const float* xcur = (const float*)(p.ws + WS_XCUR);
  bf16_t* H = (bf16_t*)(p.ws + WS_H);
  float* aff = (float*)(p.ws + WS_AFF);
  for (int tok = p.bid * 4 + wave; tok < NTOK; tok += p.nb * 4) {
    const float* x = from_inputs ? (tok < NPR ? p.in[0] + (size_t)tok * DM : p.in[1] + (size_t)(tok - NPR) * DM) : xcur + (size_t)tok * DM;
    const int mr = modrow(tok);
    const float* sh = mod + (size_t)(layer * 3 + mr) * 6144 + slot_shift * 1024;
    const float* scl = sh + 1024;
    float4 xv[4];
    float ss = 0.f;
#pragma unroll
    for (int i = 0; i < 4; ++i) xv[i] = *(const float4*)(x + (i * 64 + lane) * 4);
    if (!ROUTER && !from_inputs) {
      moe_combine_row(p, tok, 0, lane, xv);
      float* xw = (float*)(p.ws + WS_XCUR) + (size_t)tok * DM;
#pragma unroll
      for (int i = 0; i < 4; ++i) *(float4*)(xw + (i * 64 + lane) * 4) = xv[i];
    }
    if (ROUTER) { if (lane < 16) ((int*)(p.ws + WS_SEL))[tok * 16 + lane] = -1; }
#pragma unroll
    for (int i = 0; i < 4; ++i) ss += xv[i].x * xv[i].x + xv[i].y * xv[i].y + xv[i].z * xv[i].z + xv[i].w * xv[i].w;
    ss = wave_sum(ss, lane);
    const float rinv = rsqrtf(ss * (1.f / 1024.f) + RMS_EPS);
    float lg[16];
    if (ROUTER) {
#pragma unroll
      for (int e = 0; e < 16; ++e) lg[e] = 0.f;
    }
#pragma unroll
    for (int i = 0; i < 4; ++i) {
      const int d = (i * 64 + lane) * 4;
      const float4 gv = *(const float4*)(g + d), sv = *(const float4*)(sh + d), cv = *(const float4*)(scl + d);
      float h[4];
      h[0] = xv[i].x * rinv * gv.x * (1.f + cv.x) + sv.x;
      h[1] = xv[i].y * rinv * gv.y * (1.f + cv.y) + sv.y;
      h[2] = xv[i].z * rinv * gv.z * (1.f + cv.z) + sv.z;
      h[3] = xv[i].w * rinv * gv.w * (1.f + cv.w) + sv.w;
      uint2 o; o.x = pk2(h[0], h[1]); o.y = pk2(h[2], h[3]);
      *(uint2*)(H + (size_t)tok * DM + d) = o;
      if (ROUTER) {
#pragma unroll
        for (int j = 0; j < 4; ++j) {
          const float4* rr = (const float4*)(rw + (size_t)(d + j) * 16);
#pragma unroll
          for (int q = 0; q < 4; ++q) {
            const float4 w = rr[q];
            lg[q * 4 + 0] += h[j] * w.x; lg[q * 4 + 1] += h[j] * w.y; lg[q * 4 + 2] += h[j] * w.z; lg[q * 4 + 3] += h[j] * w.w;
          }
        }
      }
    }
    if (ROUTER) {
      float mx = -1e30f;
#pragma unroll
      for (int e = 0; e < 16; ++e) { lg[e] = wave_sum(lg[e], lane); mx = fmaxf(mx, lg[e]); }
      float se = 0.f;
#pragma unroll
      for (int e = 0; e < 16; ++e) { lg[e] = expf(lg[e] - mx); se += lg[e]; }
      const float inv = 1.f / se;
      const int grp = tok >= NPR, nloc = tok - grp * NPR;
      float mine = 0.f;
#pragma unroll
      for (int e = 0; e < 16; ++e) mine = (lane == e) ? lg[e] * inv : mine;
      if (lane < 16) aff[(size_t)(grp * 16 + lane) * 4096 + nloc] = mine;
    }
  }
}

__device__ __forceinline__ void ph_router(const C& p, const float* g, int layer, const float* rw) {
  const int tid = p.tid, lane = tid & 63, wave = tid >> 6;
  const float* mod = (const float*)(p.ws + WS_MOD);
  const float* xcur = (const float*)(p.ws + WS_XCUR);
  bf16_t* H = (bf16_t*)(p.ws + WS_H);
  float* aff = (float*)(p.ws + WS_AFF);
  int* SEL = (int*)(p.ws + WS_SEL);
  for (int base = (p.bid * 4 + wave) * 3; base < NTOK; base += p.nb * 12) {
    float rinv[3]; const float* sh[3];
#pragma unroll
    for (int j = 0; j < 3; ++j) {
      const int tok = base + j;
      const float* x = xcur + (size_t)tok * DM;
      float ss = 0.f;
#pragma unroll
      for (int i = 0; i < 4; ++i) { const float4 v = *(const float4*)(x + (i * 64 + lane) * 4); ss += v.x * v.x + v.y * v.y + v.z * v.z + v.w * v.w; }
      ss = wave_sum(ss, lane);
      rinv[j] = rsqrtf(ss * (1.f / 1024.f) + RMS_EPS);
      sh[j] = mod + (size_t)(layer * 3 + modrow(tok)) * 6144 + 3 * 1024;
      if (lane < 16) SEL[tok * 16 + lane] = -1;
    }
    float lg[3][16];
#pragma unroll
    for (int j = 0; j < 3; ++j)
#pragma unroll
      for (int e = 0; e < 16; ++e) lg[j][e] = 0.f;
#pragma unroll 1
    for (int i = 0; i < 4; ++i) {
      const int d = (i * 64 + lane) * 4;
      const float4 gv = *(const float4*)(g + d);
      float h[3][4];
#pragma unroll
      for (int j = 0; j < 3; ++j) {
        const float4 xq = *(const float4*)(xcur + (size_t)(base + j) * DM + d);
        const float4 sv = *(const float4*)(sh[j] + d), cv = *(const float4*)(sh[j] + 1024 + d);
        h[j][0] = xq.x * rinv[j] * gv.x * (1.f + cv.x) + sv.x;
        h[j][1] = xq.y * rinv[j] * gv.y * (1.f + cv.y) + sv.y;
        h[j][2] = xq.z * rinv[j] * gv.z * (1.f + cv.z) + sv.z;
        h[j][3] = xq.w * rinv[j] * gv.w * (1.f + cv.w) + sv.w;
        uint2 o; o.x = pk2(h[j][0], h[j][1]); o.y = pk2(h[j][2], h[j][3]);
        *(uint2*)(H + (size_t)(base + j) * DM + d) = o;
      }
#pragma unroll
      for (int jj = 0; jj < 4; ++jj) {
        const float4* rr = (const float4*)(rw + (size_t)(d + jj) * 16);
#pragma unroll
        for (int q = 0; q < 4; ++q) {
          const float4 w = rr[q];
#pragma unroll
          for (int j = 0; j < 3; ++j) {
            lg[j][q * 4 + 0] += h[j][jj] * w.x; lg[j][q * 4 + 1] += h[j][jj] * w.y; lg[j][q * 4 + 2] += h[j][jj] * w.z; lg[j][q * 4 + 3] += h[j][jj] * w.w;
          }
        }
      }
    }
#pragma unroll
    for (int j = 0; j < 3; ++j) {
      const int tok = base + j;
      float mx = -1e30f;
#pragma unroll
      for (int e = 0; e < 16; ++e) { lg[j][e] = wave_sum(lg[j][e], lane); mx = fmaxf(mx, lg[j][e]); }
      float se = 0.f;
#pragma unroll
      for (int e = 0; e < 16; ++e) { lg[j][e] = expf(lg[j][e] - mx); se += lg[j][e]; }
      const float inv = 1.f / se;
      const int grp = tok >= NPR, nloc = tok - grp * NPR;
      float mine = 0.f;
#pragma unroll
      for (int e = 0; e < 16; ++e) mine = (lane == e) ? lg[j][e] * inv : mine;
      if (lane < 16) aff[(size_t)(grp * 16 + lane) * 4096 + nloc] = mine;
    }
  }
}

__device__ __forceinline__ void ph_gemm_in0(const C& p) {
  const bf16_t* H = (const bf16_t*)(p.ws + WS_H);
  const float* W = p.in[11];
  float* Z = (float*)(p.ws + WS_Z);
  for (int t = p.vb; t < 48 * 27; t += p.nb) {
    int mt_, nt_; tile_mn(t, 48, 27, mt_, nt_);
    const int m0 = mt_ * 128, n0 = nt_ * 128;
    gemm_tile<1>(p.tid, 1024,
      [=](int m, int k) { return *(const uint4*)(H + (size_t)(m0 + m) * DM + k); },
      [=](int, int k, int n) { return ldg4(W, (unsigned)(k * IN0C + n0 + n)); },
      [=](int m, int n, const float (&v)[1][4]) {
#pragma unroll
        for (int i = 0; i < 4; ++i) Z[(size_t)(m0 + m + i) * IN0C + n0 + n] = v[0][i];
      });
  }
}

__device__ __forceinline__ void ph_mix(const C& p) {
  const int tid = p.tid, lane = tid & 63, wave = tid >> 6;
  const float* Z = (const float*)(p.ws + WS_Z);
  float* ZM = (float*)(p.ws + WS_ZM);
  float* OA = (float*)(p.ws + WS_OPSA);
  bf16_t* YC = (bf16_t*)(p.ws + WS_YCAT);
  const float* cw = p.in[12]; const float* mu = p.in[13]; const float* kk_w = p.in[19];
  for (int tok = p.bid * 4 + wave; tok < NTOK; tok += p.nb * 4) {
    int t, T;
    if (tok < NPR) { t = tok & 255; T = 256; } else { t = (tok - NPR) & 1023; T = 1024; }
    const bool hasL = t > 0, hasR = t < T - 1;
    const float* zc = Z + (size_t)tok * IN0C;
    const float* zl = zc - IN0C; const float* zr = zc + IN0C;
    {
      const int c = lane * 8;
      float o[8];
#pragma unroll
      for (int q = 0; q < 2; ++q) {
        const int cq = c + q * 4;
        const float4 gb = *(const float4*)(zc + cq);
        const float4 gc = *(const float4*)(zc + 512 + cq), xa = *(const float4*)(zc + 1024 + cq);
        float4 ul = make_float4(0.f, 0.f, 0.f, 0.f), ur = ul;
        if (hasL) { const float4 a = *(const float4*)(zl + 512 + cq), b = *(const float4*)(zl + 1024 + cq); ul = make_float4(a.x * b.x, a.y * b.y, a.z * b.z, a.w * b.w); }
        if (hasR) { const float4 a = *(const float4*)(zr + 512 + cq), b = *(const float4*)(zr + 1024 + cq); ur = make_float4(a.x * b.x, a.y * b.y, a.z * b.z, a.w * b.w); }
        const float4 w0 = *(const float4*)(cw + cq), w1 = *(const float4*)(cw + 512 + cq), w2 = *(const float4*)(cw + 1024 + cq);
        o[q * 4 + 0] = gb.x * (w0.x * ul.x + w1.x * gc.x * xa.x + w2.x * ur.x);
        o[q * 4 + 1] = gb.y * (w0.y * ul.y + w1.y * gc.y * xa.y + w2.y * ur.y);
        o[q * 4 + 2] = gb.z * (w0.z * ul.z + w1.z * gc.z * xa.z + w2.z * ur.z);
        o[q * 4 + 3] = gb.w * (w0.w * ul.w + w1.w * gc.w * xa.w + w2.w * ur.w);
      }
      uint4 w; w.x = pk2(o[0], o[1]); w.y = pk2(o[2], o[3]); w.z = pk2(o[4], o[5]); w.w = pk2(o[6], o[7]);
      *(uint4*)(YC + (size_t)tok * DM + c) = w;
    }
#pragma unroll
    for (int i = 0; i < 8; ++i) {
      const int c = i * 256 + lane * 4;
      if (c < ZMC) {
        const float4 a = *(const float4*)(zc + 1536 + c);
        float4 l = make_float4(0.f, 0.f, 0.f, 0.f), r = l;
        if (hasL) l = *(const float4*)(zl + 1536 + c);
        if (hasR) r = *(const float4*)(zr + 1536 + c);
        const float4 m = *(const float4*)(mu + c);
        float4 o;
        o.x = a.x + m.x * (0.5f * (l.x + r.x) - a.x);
        o.y = a.y + m.y * (0.5f * (l.y + r.y) - a.y);
        o.z = a.z + m.z * (0.5f * (l.z + r.z) - a.z);
        o.w = a.w + m.w * (0.5f * (l.w + r.w) - a.w);
        *(float4*)(ZM + (size_t)tok * ZMC + c) = o;
        if (i < 2) {
          const int h = c >> 6, j = c & 63;
          *(float4*)(OA + ((size_t)(tok * 8 + h) * 2 + 1) * 64 + j) = o;
        } else if (i < 4) {
          const int ck = c - 512;
          const float4 kw = *(const float4*)(kk_w + ck);
          float4 q = make_float4(o.x * kw.x, o.y * kw.y, o.z * kw.z, o.w * kw.w);
          float ss = q.x * q.x + q.y * q.y + q.z * q.z + q.w * q.w;
          ss += swz<1>(ss); ss += swz<2>(ss); ss += swz<4>(ss); ss += swz<8>(ss);
          const float rn = -rsqrtf(fmaxf(ss, 1e-12f));
          q.x *= rn; q.y *= rn; q.z *= rn; q.w *= rn;
          const int h = ck >> 6, j = ck & 63;
          *(float4*)(OA + ((size_t)(tok * 8 + h) * 2 + 0) * 64 + j) = q;
        }
      }
    }
  }
}

__device__ __forceinline__ void ph_lora(const C& p) {
  const float* ZM = (const float*)(p.ws + WS_ZM);
  const float* OA = (const float*)(p.ws + WS_OPSA);
  float* OB = (float*)(p.ws + WS_OPSB);
  float* GG = (float*)(p.ws + WS_GG);
  for (int t = p.vb; t < 960; t += p.nb) {
    const int g = t / 192, rem = t % 192;
    const int m0 = (rem >> 2) * 128, n0 = (rem & 3) * 128;
    if (g < 2) {
      const int d = g;
      const float* W = p.in[15] + (size_t)d * 64 * 512;
      const float* w0 = p.in[14] + d * 512;
      gemm_tile<1>(p.tid, 64,
        [=](int m, int k) {
          const float* s = ZM + (size_t)(m0 + m) * ZMC + 1536 + d * 64 + k;
          const float4 a = *(const float4*)s, b = *(const float4*)(s + 4);
          uint4 o; o.x = pk2(ftanh_(a.x), ftanh_(a.y)); o.y = pk2(ftanh_(a.z), ftanh_(a.w)); o.z = pk2(ftanh_(b.x), ftanh_(b.y)); o.w = pk2(ftanh_(b.z), ftanh_(b.w));
          return o; },
        [=](int, int k, int n) { return ldg4(W, (unsigned)(k * 512 + n0 + n)); },
        [=](int m, int n, const float (&v)[1][4]) {
          const int nn = n0 + n, h = nn >> 6, j = nn & 63;
          const float b0 = w0[nn];
#pragma unroll
          for (int i = 0; i < 4; ++i) {
            const int tok = m0 + m + i;
            OB[(((size_t)d * NTOK + tok) * 8 + h) * 192 + j] = __builtin_amdgcn_exp2f((-DECAY_SCALE * 1.4426950408889634f) * fsigmoid_(b0 + v[0][i]));
          }
        });
    } else if (g < 4) {
      const int d = g - 2;
      const float* W = p.in[17] + (size_t)d * 64 * 512;
      const float* a0 = p.in[16] + d * 512;
      const float* ka = p.in[20];
      gemm_tile<1>(p.tid, 64,
        [=](int m, int k) {
          const float* s = ZM + (size_t)(m0 + m) * ZMC + 1664 + d * 64 + k;
          const float4 a = *(const float4*)s, b = *(const float4*)(s + 4);
          uint4 o; o.x = pk2(a.x, a.y); o.y = pk2(a.z, a.w); o.z = pk2(b.x, b.y); o.w = pk2(b.z, b.w);
          return o; },
        [=](int, int k, int n) { return ldg4(W, (unsigned)(k * 512 + n0 + n)); },
        [=](int m, int n, const float (&v)[1][4]) {
          const int nn = n0 + n, h = nn >> 6, j = nn & 63;
          const float b0 = a0[nn];
#pragma unroll
          for (int i = 0; i < 4; ++i) {
            const int tok = m0 + m + i;
            OB[(((size_t)d * NTOK + tok) * 8 + h) * 192 + 64 + j] = fsigmoid_(b0 + v[0][i]);
          }
        });
    } else {
      const float* W = p.in[18];
      gemm_tile<1>(p.tid, 128,
        [=](int m, int k) {
          const float* s = ZM + (size_t)(m0 + m) * ZMC + 1792 + k;
          const float4 a = *(const float4*)s, b = *(const float4*)(s + 4);
          uint4 o; o.x = pk2(fsigmoid_(a.x), fsigmoid_(a.y)); o.y = pk2(fsigmoid_(a.z), fsigmoid_(a.w)); o.z = pk2(fsigmoid_(b.x), fsigmoid_(b.y)); o.w = pk2(fsigmoid_(b.z), fsigmoid_(b.w));
          return o; },
        [=](int, int k, int n) { return ldg4(W, (unsigned)(k * 512 + n0 + n)); },
        [=](int m, int n, const float (&v)[1][4]) {
#pragma unroll
          for (int i = 0; i < 4; ++i) GG[(size_t)(m0 + m + i) * 512 + n0 + n] = v[0][i];
        });
    }
  }
}

#define CH_L 128
__device__ __forceinline__ int pq_entry(int ch, int c) { return ch < 32 ? ch * 8 + c : 256 + (ch - 32) * 2 + c; }
__device__ __forceinline__ void ph_scan(const C& p) {
  const int lane = p.tid & 63;
  const int wave = __builtin_amdgcn_readfirstlane(p.tid >> 6);
  const float* ZM = (const float*)(p.ws + WS_ZM);
  const float* OA = (const float*)(p.ws + WS_OPSA);
  const float* OB = (const float*)(p.ws + WS_OPSB);
  float* YD = (float*)(p.ws + WS_YD);
  float* UD = (float*)(p.ws + WS_UD);
  float* PQ = (float*)(p.ws + WS_PQ);
  const int d = wave >> 1, ident = wave & 1;
  for (int it = p.bid; it < 384; it += p.nb) {
    int b, h, c, T, tok0, ch;
    if (it < 128) { b = it >> 6; h = (it >> 3) & 7; c = it & 7; T = 1024; tok0 = NPR + b * 1024; ch = (b * 8 + h) * 2 + d; }
    else { const int i2 = it - 128; b = i2 >> 4; h = (i2 >> 1) & 7; c = i2 & 1; T = 256; tok0 = b * 256; ch = 32 + (b * 8 + h) * 2 + d; }
    if (ident && c == 0) continue;
    float S[64];
    if (ident) {
#pragma unroll
      for (int k = 0; k < 64; ++k) S[k] = (k == lane) ? 1.f : 0.f;
    } else if (c == 0 && it < 128) {
      const float* s0 = p.in[2] + ((size_t)((b * 2 + d) * 8 + h) * 64 + lane) * 64;
#pragma unroll
      for (int k = 0; k < 64; k += 4) { const float4 v = *(const float4*)(s0 + k); S[k] = v.x; S[k + 1] = v.y; S[k + 2] = v.z; S[k + 3] = v.w; }
    } else {
#pragma unroll
      for (int k = 0; k < 64; ++k) S[k] = 0.f;
    }
    const int tinc = d ? -1 : 1;
    const int tokA = tok0 + (d ? T - 1 - c * CH_L : c * CH_L);
    float* yout = ident ? UD : YD;
    float ob[4][5], vb[4];
    const float ka_l = p.in[20][h * 64 + lane];
    auto fetch = [&](int j, int sidx) {
      const int sc = sidx < CH_L ? sidx : CH_L - 1;
      const int tk = tokA + sc * tinc;
      const float* pa = OA + (size_t)(tk * 8 + h) * 128 + lane;
      const float* pb = OB + (((size_t)d * NTOK + tk) * 8 + h) * 192 + lane;
      const float nk_ = pa[0], a_ = pb[64], kp_ = ZM[(size_t)tk * ZMC + 512 + h * 64 + lane];
      ob[j][0] = nk_; ob[j][1] = pa[64]; ob[j][2] = pb[0];
      ob[j][3] = -nk_ * a_;
      ob[j][4] = kp_ * (1.f + (a_ - 1.f) * ka_l);
      vb[j] = ident ? 0.f : ZM[(size_t)tk * ZMC + 1024 + h * 64 + lane];
    };
#pragma unroll
    for (int j = 0; j < 4; ++j) fetch(j, j);
#pragma unroll 1
    for (int s0 = 0; s0 < CH_L; s0 += 4) {
#pragma unroll
      for (int j = 0; j < 4; ++j) {
        const int tok = tokA + (s0 + j) * tinc;
        const int i_nkk = __builtin_bit_cast(int, ob[j][0]), i_r = __builtin_bit_cast(int, ob[j][1]);
        const int i_w = __builtin_bit_cast(int, ob[j][2]), i_b = __builtin_bit_cast(int, ob[j][3]), i_kd = __builtin_bit_cast(int, ob[j][4]);
        const float vv = vb[j];
        float sa0 = 0.f, sa1 = 0.f;
#pragma unroll
        for (int k = 0; k < 64; k += 2) {
          sa0 += S[k] * __builtin_bit_cast(float, __builtin_amdgcn_readlane(i_nkk, k));
          sa1 += S[k + 1] * __builtin_bit_cast(float, __builtin_amdgcn_readlane(i_nkk, k + 1));
        }
        const float sa = sa0 + sa1;
        float y0 = 0.f, y1 = 0.f;
#pragma unroll
        for (int k = 0; k < 64; k += 2) {
          S[k] = S[k] * __builtin_bit_cast(float, __builtin_amdgcn_readlane(i_w, k))
               + (sa * __builtin_bit_cast(float, __builtin_amdgcn_readlane(i_b, k)) + vv * __builtin_bit_cast(float, __builtin_amdgcn_readlane(i_kd, k)));
          S[k + 1] = S[k + 1] * __builtin_bit_cast(float, __builtin_amdgcn_readlane(i_w, k + 1))
               + (sa * __builtin_bit_cast(float, __builtin_amdgcn_readlane(i_b, k + 1)) + vv * __builtin_bit_cast(float, __builtin_amdgcn_readlane(i_kd, k + 1)));
          y0 += S[k] * __builtin_bit_cast(float, __builtin_amdgcn_readlane(i_r, k));
          y1 += S[k + 1] * __builtin_bit_cast(float, __builtin_amdgcn_readlane(i_r, k + 1));
        }
        yout[((size_t)d * NTOK + tok) * 512 + h * 64 + lane] = y0 + y1;
        fetch(j, s0 + j + 4);
      }
    }
    float* so = PQ + ((size_t)pq_entry(ch, c) * 2 + (ident ? 0 : 1)) * 4096 + lane * 64;
#pragma unroll
    for (int k = 0; k < 64; k += 4) *(float4*)(so + k) = make_float4(S[k], S[k + 1], S[k + 2], S[k + 3]);
  }
}

__device__ __forceinline__ void ph_scanfix(const C& p) {
  const int tid = p.tid, lane = tid & 63, wave = tid >> 6;
  float* Sa = (float*)smem;
  float* Sb = Sa + 64 * 65;
  float* Pl = Sb + 64 * 65;
  float* YD = (float*)(p.ws + WS_YD);
  const float* UD = (const float*)(p.ws + WS_UD);
  const float* PQ = (const float*)(p.ws + WS_PQ);
  for (int it = p.bid; it < 480; it += p.nb) {
    int ch, c, nch;
    if (it < 224) { ch = it / 7; c = 1 + it % 7; nch = 8; } else { ch = 32 + (it - 224); c = 1; nch = 2; }
    int b, h, d, T, tok0;
    if (ch < 32) { b = ch >> 4; h = (ch >> 1) & 7; d = ch & 1; T = 1024; tok0 = NPR + b * 1024; }
    else { const int c2 = ch - 32; b = c2 >> 4; h = (c2 >> 1) & 7; d = c2 & 1; T = 256; tok0 = b * 256; }
    { const float* q0 = PQ + ((size_t)pq_entry(ch, 0) * 2 + 1) * 4096;
      for (int i = tid; i < 4096; i += 256) Sa[(i >> 6) * 65 + (i & 63)] = q0[i]; }
    float* cur = Sa; float* nxt = Sb;
    const bool emit = (ch >= 32) && (c == nch - 1);
    const int nmul = (c - 1) + (emit ? 1 : 0);
    const int v = tid >> 2, kq = (tid & 3) * 16;
    for (int m = 0; m < nmul; ++m) {
      const int cc = 1 + m;
      const float* Pg = PQ + ((size_t)pq_entry(ch, cc) * 2 + 0) * 4096;
      const float* Qg = Pg + 4096;
      __syncthreads();
      for (int i = tid; i < 1024; i += 256) *(float4*)(Pl + i * 4) = *(const float4*)(Pg + i * 4);
      __syncthreads();
      float acc[16];
#pragma unroll
      for (int j = 0; j < 16; j += 4) { const float4 q = *(const float4*)(Qg + v * 64 + kq + j); acc[j] = q.x; acc[j + 1] = q.y; acc[j + 2] = q.z; acc[j + 3] = q.w; }
      for (int i = 0; i < 64; ++i) {
        const float a = cur[v * 65 + i];
#pragma unroll
        for (int j = 0; j < 16; j += 4) {
          const float4 pv = *(const float4*)(Pl + i * 64 + kq + j);
          acc[j] += a * pv.x; acc[j + 1] += a * pv.y; acc[j + 2] += a * pv.z; acc[j + 3] += a * pv.w;
        }
      }
      if (emit && m == nmul - 1) {
        float* so = p.out + O_ST + ((size_t)((b * 2 + d) * 8 + h) * 64 + v) * 64 + kq;
#pragma unroll
        for (int j = 0; j < 16; j += 4) *(float4*)(so + j) = make_float4(acc[j], acc[j + 1], acc[j + 2], acc[j + 3]);
      } else {
#pragma unroll
        for (int j = 0; j < 16; ++j) nxt[v * 65 + kq + j] = acc[j];
        float* t = cur; cur = nxt; nxt = t;
      }
    }
    __syncthreads();
    float sr[64];
#pragma unroll
    for (int i = 0; i < 64; ++i) sr[i] = cur[lane * 65 + i];
    __syncthreads();
    float* Ul = Sb + wave * 2048;
    const int tinc = d ? -1 : 1;
    const int tokA = tok0 + (d ? T - 1 - c * CH_L : c * CH_L);
    {
      float uv[32];
#pragma unroll
      for (int s = 0; s < 32; ++s) uv[s] = UD[((size_t)d * NTOK + (tokA + (wave * 32 + s) * tinc)) * 512 + h * 64 + lane];
#pragma unroll
      for (int s = 0; s < 32; ++s) Ul[s * 64 + lane] = uv[s];
    }
    __syncthreads();
    float yv[32];
#pragma unroll
    for (int s = 0; s < 32; ++s) yv[s] = YD[((size_t)d * NTOK + (tokA + (wave * 32 + s) * tinc)) * 512 + h * 64 + lane];
#pragma unroll
    for (int s = 0; s < 32; ++s) {
      const int tok = tokA + (wave * 32 + s) * tinc;
      float a0 = 0.f, a1 = 0.f;
#pragma unroll
      for (int i = 0; i < 64; i += 4) {
        const float4 u = *(const float4*)(Ul + s * 64 + i);
        a0 += sr[i] * u.x; a1 += sr[i + 1] * u.y; a0 += sr[i + 2] * u.z; a1 += sr[i + 3] * u.w;
      }
      YD[((size_t)d * NTOK + tok) * 512 + h * 64 + lane] = yv[s] + (a0 + a1);
    }
    __syncthreads();
  }
}

__device__ __forceinline__ void ph_post(const C& p) {
  const int tid = p.tid, lane = tid & 63, wave = tid >> 6;
  const float* ZM = (const float*)(p.ws + WS_ZM);
  const float* YD = (const float*)(p.ws + WS_YD);
  const float* GG = (const float*)(p.ws + WS_GG);
  bf16_t* YC = (bf16_t*)(p.ws + WS_YCAT);
  const float* rk = p.in[21]; const float* lnw = p.in[22]; const float* lnb = p.in[23];
  for (int tok = p.bid * 4 + wave; tok < NTOK; tok += p.nb * 4) {
    const int c = lane * 8;
    float y[8], r[8], k[8], v[8], g[8];
#pragma unroll
    for (int q = 0; q < 2; ++q) {
      const float4 a = *(const float4*)(YD + (size_t)tok * 512 + c + q * 4), b = *(const float4*)(YD + ((size_t)NTOK + tok) * 512 + c + q * 4);
      y[q * 4] = a.x + b.x; y[q * 4 + 1] = a.y + b.y; y[q * 4 + 2] = a.z + b.z; y[q * 4 + 3] = a.w + b.w;
      const float4 rr = *(const float4*)(ZM + (size_t)tok * ZMC + c + q * 4), kk = *(const float4*)(ZM + (size_t)tok * ZMC + 512 + c + q * 4), vv = *(const float4*)(ZM + (size_t)tok * ZMC + 1024 + c + q * 4);
      r[q * 4] = rr.x; r[q * 4 + 1] = rr.y; r[q * 4 + 2] = rr.z; r[q * 4 + 3] = rr.w;
      k[q * 4] = kk.x; k[q * 4 + 1] = kk.y; k[q * 4 + 2] = kk.z; k[q * 4 + 3] = kk.w;
      v[q * 4] = vv.x; v[q * 4 + 1] = vv.y; v[q * 4 + 2] = vv.z; v[q * 4 + 3] = vv.w;
      const float4 gg = *(const float4*)(GG + (size_t)tok * 512 + c + q * 4);
      g[q * 4] = gg.x; g[q * 4 + 1] = gg.y; g[q * 4 + 2] = gg.z; g[q * 4 + 3] = gg.w;
    }
    float sm = 0.f, bn = 0.f;
#pragma unroll
    for (int i = 0; i < 8; ++i) { sm += y[i]; bn += r[i] * k[i] * rk[c + i]; }
    sm += swz<1>(sm); sm += swz<2>(sm); sm += swz<4>(sm);
    bn += swz<1>(bn); bn += swz<2>(bn); bn += swz<4>(bn);
    const float mean = sm * (1.f / 64.f);
    float vr = 0.f;
#pragma unroll
    for (int i = 0; i < 8; ++i) { const float dd = y[i] - mean; vr += dd * dd; }
    vr += swz<1>(vr); vr += swz<2>(vr); vr += swz<4>(vr);
    const float rs = rsqrtf(vr * (1.f / 64.f) + GN_EPS);
    float o[8];
#pragma unroll
    for (int i = 0; i < 8; ++i) o[i] = ((y[i] - mean) * rs * lnw[c + i] + lnb[c + i] + bn * v[i]) * g[i];
    uint4 w; w.x = pk2(o[0], o[1]); w.y = pk2(o[2], o[3]); w.z = pk2(o[4], o[5]); w.w = pk2(o[6], o[7]);
    *(uint4*)(YC + (size_t)tok * DM + 512 + c) = w;
  }
}

__device__ __forceinline__ void ph_gemm_out(const C& p, const float* W, int layer, bool from_inputs) {
  const bf16_t* A = (const bf16_t*)(p.ws + WS_YCAT);
  const float* mod = (const float*)(p.ws + WS_MOD);
  float* X = (float*)(p.ws + WS_XCUR);
  for (int t = p.vb; t < 48 * 8; t += p.nb) {
    int mt_, nt_; tile_mn(t, 48, 8, mt_, nt_);
    const int m0 = mt_ * 128, n0 = nt_ * 128;
    const float* gate = mod + (size_t)(layer * 3 + modrow(m0)) * 6144 + 2 * 1024;
    const float* xin = from_inputs ? (m0 < NPR ? p.in[0] + (size_t)m0 * DM : p.in[1] + (size_t)(m0 - NPR) * DM) : X + (size_t)m0 * DM;
    const float* xr_ = xin + (size_t)(p.tid >> 1) * DM + n0 + (p.tid & 1) * 64;
    const float t0_ = xr_[0], t1_ = xr_[32];
    gemm_tile<1>(p.tid, 1024,
      [=](int m, int k) { return *(const uint4*)(A + (size_t)(m0 + m) * DM + k); },
      [=](int, int k, int n) { return ldg4(W, (unsigned)(k * DM + n0 + n)); },
      [=](int m, int n, const float (&v)[1][4]) {
        const float gt = gate[n0 + n];
#pragma unroll
        for (int i = 0; i < 4; ++i) X[(size_t)(m0 + m + i) * DM + n0 + n] = xin[(size_t)(m + i) * DM + n0 + n] + gt * v[0][i];
      });
    asm volatile("" :: "v"(t0_), "v"(t1_));
  }
}

__device__ __forceinline__ void ph_topk(const C& p) {
  const int tid = p.tid;
  unsigned* keys = (unsigned*)smem;
  unsigned* hist = keys + 4096;
  unsigned* ctl = hist + 256;
  unsigned* gsum = ctl + 8;
  const float* aff = (const float*)(p.ws + WS_AFF);
  int* IDX = (int*)(p.ws + WS_IDX);
  int* SEL = (int*)(p.ws + WS_SEL);
  for (int it = p.bid; it < 32; it += p.nb) {
    const int grp = it >> 4, e = it & 15;
    const int n = grp ? NSA : NPR, cap = n >> 3;
    const float* a = aff + (size_t)(grp * 16 + e) * 4096;
    for (int i = tid; i < n; i += 256) keys[i] = __float_as_uint(a[i]);
    unsigned prefix = 0, mask = 0, need = cap;
    for (int pass = 0; pass < 4; ++pass) {
      const int shift = 24 - 8 * pass;
      hist[tid] = 0;
      __syncthreads();
      for (int i = tid; i < n; i += 256) { const unsigned k = keys[i]; if ((k & mask) == prefix) atomicAdd(&hist[(k >> shift) & 255u], 1u); }
      __syncthreads();
      if (tid < 16) {
        unsigned g = 0;
#pragma unroll
        for (int j = 0; j < 16; ++j) g += hist[tid * 16 + j];
        gsum[tid] = g;
      }
      __syncthreads();
      {
        const unsigned hb = hist[tid];
        const int g = tid >> 4, bl = tid & 15;
        unsigned cum = 0;
#pragma unroll
        for (int q = 1; q < 16; ++q) {
          const unsigned gv = gsum[(g + q) & 15], hv = hist[(tid & ~15) + ((bl + q) & 15)];
          cum += (g + q < 16) ? gv : 0u;
          cum += (bl + q < 16) ? hv : 0u;
        }
        if (cum < need && cum + hb >= need) { ctl[0] = tid; ctl[1] = need - cum; }
      }
      __syncthreads();
      prefix |= ctl[0] << shift; mask |= 255u << shift; need = ctl[1];
      __syncthreads();
    }
    if (tid == 0) { ctl[2] = 0; ctl[3] = 0; }
    __syncthreads();
    const unsigned T = prefix;
    for (int i = tid; i < n; i += 256) if (keys[i] == T) atomicAdd(&ctl[3], 1u);
    __syncthreads();
    const bool all_eq = ctl[3] == need;
    const int obase = e * 768 + (grp ? 512 : 0);
    for (int i = tid; i < n; i += 256) {
      const unsigned k = keys[i];
      bool sel = k > T;
      if (k == T) { if (all_eq) sel = true; else { unsigned rk = 0; for (int j = 0; j < i; ++j) rk += (keys[j] == T); sel = rk < need; } }
      if (sel) {
        const unsigned slot = atomicAdd(&ctl[2], 1u);
        IDX[obase + slot] = i + grp * NPR;
        SEL[(i + grp * NPR) * 16 + e] = (int)(obase - e * 768 + slot);
      }
    }
    __syncthreads();
  }
}

__device__ __forceinline__ void ph_moe_up(const C& p, int layer) {
  const bf16_t* H = (const bf16_t*)(p.ws + WS_H);
  const int* IDX = (const int*)(p.ws + WS_IDX);
  bf16_t* HID = (bf16_t*)(p.ws + WS_HID);
  for (int t = p.vb; t < 1536; t += p.nb) {
    const int e = t / 96, rem = t % 96, m0 = (rem % 6) * 128, n0 = (rem / 6) * 64;
    const float* W1 = p.in[32] + ((size_t)layer * 16 + e) * 1024 * 1024;
    const float* W3 = p.in[33] + ((size_t)layer * 16 + e) * 1024 * 1024;
    const int myrow = IDX[e * 768 + m0 + (p.tid >> 1)];
    const bf16_t* arow = H + (size_t)myrow * DM;
    gemm_core<1, true>(p.tid, 1024,
      [=](int, int k) { return *(const uint4*)(arow + k); },
      [=](int, int k, int n) { const int seg = n >> 5; return ldg4((seg & 1) ? W3 : W1, (unsigned)(k * 1024 + n0 + (seg >> 1) * 32 + (n & 31))); },
      [=](int m, int n, const float (&v)[2][4]) {
#pragma unroll
        for (int i = 0; i < 4; ++i) {
          const float a = v[0][i];
          HID[((size_t)e * 768 + m0 + m + i) * 1024 + n0 + n] = f2bf(a * fsigmoid_(a) * v[1][i]);
        }
      });
  }
}

__device__ __forceinline__ void ph_moe_down(const C& p, int layer) {
  const bf16_t* HID = (const bf16_t*)(p.ws + WS_HID);
  bf16_t* YE = (bf16_t*)(p.ws + WS_YE);
  for (int t = p.vb; t < 768; t += p.nb) {
    const int e = t / 48, rem = t % 48, m0 = (rem % 6) * 128, n0 = (rem / 6) * 128;
    const float* W2 = p.in[34] + ((size_t)layer * 16 + e) * 1024 * 1024;
    const bf16_t* A = HID + ((size_t)e * 768 + m0) * 1024;
    bf16_t* Y = YE + ((size_t)e * 768 + m0) * 1024 + n0;
    gemm_tile<1>(p.tid, 1024,
      [=](int m, int k) { return *(const uint4*)(A + (size_t)m * 1024 + k); },
      [=](int, int k, int n) { return ldg4(W2, (unsigned)(k * 1024 + n0 + n)); },
      [=](int m, int n, const float (&v)[1][4]) {
#pragma unroll
        for (int i = 0; i < 4; ++i) Y[(size_t)(m + i) * 1024 + n] = f2bf(v[0][i]);
      });
  }
}

__device__ __forceinline__ void ph_gemm_in1(const C& p) {
  const bf16_t* H = (const bf16_t*)(p.ws + WS_H);
  const float* W = p.in[25];
  float* Z1 = (float*)(p.ws + WS_Z1);
  for (int t = p.vb; t < 48 * 6; t += p.nb) {
    int mt_, nt_; tile_mn(t, 48, 6, mt_, nt_);
    const int m0 = mt_ * 128, n0 = nt_ * 128;
    gemm_tile<1>(p.tid, 1024,
      [=](int m, int k) { return *(const uint4*)(H + (size_t)(m0 + m) * DM + k); },
      [=](int, int k, int n) { return (n0 + n < IN1C) ? ldg4(W, (unsigned)(k * IN1C + n0 + n)) : make_float4(0.f, 0.f, 0.f, 0.f); },
      [=](int m, int n, const float (&v)[1][4]) {
        if (n0 + n < IN1C) {
#pragma unroll
          for (int i = 0; i < 4; ++i) Z1[(size_t)(m0 + m + i) * IN1C + n0 + n] = v[0][i];
        }
      });
  }
}

__device__ __forceinline__ int kofs(int seq) { return seq < 16 ? seq * 256 : 4096 + (seq - 16) * 1280; }
__device__ __forceinline__ void keyrow_geom(int row, int& seq, int& pos, int& nk) {
  if (row < NPR) { seq = row >> 8; pos = row & 255; nk = 256; }
  else if (row < NTOK) { seq = 16 + ((row - NPR) >> 10); pos = 256 + ((row - NPR) & 1023); nk = 1280; }
  else { seq = 16 + ((row - NTOK) >> 8); pos = (row - NTOK) & 255; nk = 1280; }
}

__device__ __forceinline__ int kfrag_off(int key, int d) { return (d >> 4) * 512 + ((d >> 3) & 1) * 256 + key * 8 + (d & 7); }

__device__ __forceinline__ void ph_mla_norm(const C& p) {
  const int tid = p.tid, lane = tid & 63, wave = tid >> 6;
  const float* Z1 = (const float*)(p.ws + WS_Z1);
  const float* tab = (const float*)(p.ws + WS_ROPE);
  bf16_t* CQN = (bf16_t*)(p.ws + WS_CQN);
  bf16_t* CKVN = (bf16_t*)(p.ws + WS_CKVN);
  bf16_t* KH = (bf16_t*)(p.ws + WS_KH);
  const float* qn = p.in[26]; const float* kvn = p.in[27];
  for (int row = p.bid * 4 + wave; row < NKROW; row += p.nb * 4) {
    if (row < NTOK) {
      const float* z = Z1 + (size_t)row * IN1C;
      float cq[6], ss = 0.f;
#pragma unroll
      for (int i = 0; i < 6; ++i) { cq[i] = z[i * 64 + lane]; ss += cq[i] * cq[i]; }
      ss = wave_sum(ss, lane);
      const float rq = rsqrtf(ss * (1.f / 384.f) + RMS_EPS);
#pragma unroll
      for (int i = 0; i < 6; ++i) CQN[(size_t)row * 384 + i * 64 + lane] = f2bf(cq[i] * rq * qn[i * 64 + lane]);
      float ck[4], s2 = 0.f;
#pragma unroll
      for (int i = 0; i < 4; ++i) { ck[i] = z[384 + i * 64 + lane]; s2 += ck[i] * ck[i]; }
      s2 = wave_sum(s2, lane);
      const float rk = rsqrtf(s2 * (1.f / 256.f) + RMS_EPS);
#pragma unroll
      for (int i = 0; i < 4; ++i) {
        const float o = ck[i] * rk * kvn[i * 64 + lane];
        CKVN[(size_t)row * 256 + i * 64 + lane] = f2bf(o);
        if (row < NPR) p.out[O_CKV + (size_t)row * 256 + i * 64 + lane] = o;
      }
      float kp = z[640 + lane];
      if (row < NPR) {
        p.out[O_KPE + (size_t)row * 64 + lane] = kp;
      } else {
        const int tt = (row - NPR) & 1023;
        const int grp = lane >> 5, idx = lane & 31, f = idx & 15;
        const int pos = grp ? (tt & 63) : (tt >> 6);
        const float cs = tab[(pos * 16 + f) * 2], sn = tab[(pos * 16 + f) * 2 + 1];
        const float pr = swz<16>(kp);
        kp = (idx < 16) ? (kp * cs - pr * sn) : (pr * sn + kp * cs);
      }
      { int seq, pos, nk; keyrow_geom(row, seq, pos, nk);
        const bf16_t kb = f2bf(kp);
#pragma unroll
        for (int hh = 0; hh < 8; ++hh) KH[((size_t)kofs(seq) * 8 + (size_t)hh * nk + (pos & ~31)) * 192 + kfrag_off(pos & 31, 128 + lane)] = kb; }
    } else {
      const int cr = row - NTOK;
      const float* c = p.in[3] + (size_t)cr * 256;
#pragma unroll
      for (int i = 0; i < 4; ++i) CKVN[(size_t)row * 256 + i * 64 + lane] = f2bf(c[i * 64 + lane]);
      { int seq, pos, nk; keyrow_geom(row, seq, pos, nk);
        const bf16_t kb = f2bf(p.in[4][(size_t)cr * 64 + lane]);
#pragma unroll
        for (int hh = 0; hh < 8; ++hh) KH[((size_t)kofs(seq) * 8 + (size_t)hh * nk + (pos & ~31)) * 192 + kfrag_off(pos & 31, 128 + lane)] = kb; }
    }
  }
}

__device__ __forceinline__ void ph_mla_qkv(const C& p) {
  const bf16_t* CQN = (const bf16_t*)(p.ws + WS_CQN);
  const bf16_t* CKVN = (const bf16_t*)(p.ws + WS_CKVN);
  const float* tab = (const float*)(p.ws + WS_ROPE);
  bf16_t* QB = (bf16_t*)(p.ws + WS_QBUF);
  bf16_t* KH = (bf16_t*)(p.ws + WS_KH);
  bf16_t* VT = (bf16_t*)(p.ws + WS_VT);
  const float* Wq = p.in[28]; const float* Wkv = p.in[29];
  for (int t = p.vb; t < 576 + 832; t += p.nb) {
    if (t < 576) {
      int mt_, nt_; tile_mn(t, 48, 12, mt_, nt_);
      const int m0 = mt_ * 128, n0 = nt_ * 128;
      gemm_tile<1>(p.tid, 384,
        [=](int m, int k) { return *(const uint4*)(CQN + (size_t)(m0 + m) * 384 + k); },
        [=](int, int k, int n) { return ldg4(Wq, (unsigned)(k * 1536 + n0 + n)); },
        [=](int m, int n, const float (&v)[1][4]) {
          const int nn = n0 + n;
          const int sub = (nn % 192) >> 5;
          float o[4] = {v[0][0], v[0][1], v[0][2], v[0][3]};
          if (m0 >= NPR && sub >= 4) {
            const int idx = nn & 31, f = idx & 15;
#pragma unroll
            for (int i = 0; i < 4; ++i) {
              const int tt = (m0 + m + i - NPR) & 1023;
              const int pos = (sub == 5) ? (tt & 63) : (tt >> 6);
              const float cs = tab[(pos * 16 + f) * 2], sn = tab[(pos * 16 + f) * 2 + 1];
              const float pr = swz<16>(o[i]);
              o[i] = (idx < 16) ? (o[i] * cs - pr * sn) : (pr * sn + o[i] * cs);
            }
          }
#pragma unroll
          for (int i = 0; i < 4; ++i) QB[(size_t)(m0 + m + i) * 1536 + nn] = f2bf(o[i]);
        });
    } else {
      const int t2 = t - 576;
      int mt_, nt_; tile_mn(t2, 52, 16, mt_, nt_);
      const int m0 = mt_ * 128, n0 = nt_ * 128;
      int seq, pos0, nk; keyrow_geom(m0, seq, pos0, nk);
      const int h = n0 >> 8;
      const bool isv = (n0 & 128) != 0;
      bf16_t* kdst0 = KH + ((size_t)kofs(seq) * 8 + (size_t)h * nk) * 192;
      bf16_t* vdst = VT + ((size_t)kofs(seq) * 8 + (size_t)h * nk) * 128;
      auto alkv = [=](int m, int k) { return *(const uint4*)(CKVN + (size_t)(m0 + m) * 256 + k); };
      auto blkv = [=](int, int k, int n) { return ldg4(Wkv, (unsigned)(k * 2048 + n0 + n)); };
      if (!isv) {
        gemm_tile<1>(p.tid, 256, alkv, blkv,
          [=](int m, int n, const float (&v)[1][4]) {
#pragma unroll
            for (int i = 0; i < 4; ++i) { const int pp = pos0 + m + i; kdst0[(size_t)(pp & ~31) * 192 + kfrag_off(pp & 31, n)] = f2bf(v[0][i]); }
          });
      } else {
        gemm_tile<1>(p.tid, 256, alkv, blkv,
          [=](int m, int n, const float (&v)[1][4]) {
            const int pos = pos0 + m;
            uint2 w; w.x = pk2(v[0][0], v[0][1]); w.y = pk2(v[0][2], v[0][3]);
            const int kk = pos & 31;
            *(uint2*)(vdst + (size_t)(pos >> 5) * 4096 + (((n >> 5) * 2 + (kk >> 4)) * 2 + ((kk >> 2) & 1)) * 256 + (n & 31) * 8 + ((kk >> 3) & 1) * 4) = w;
          });
      }
    }
  }
}

__device__ __forceinline__ void attn_item(const C& p, int seq, int hd, int qtok0, int tid) {
  const int lane = tid & 63, wave = tid >> 6, l31 = lane & 31, lh = lane >> 5;
  const bf16_t* QB = (const bf16_t*)(p.ws + WS_QBUF);
  const bf16_t* KH = (const bf16_t*)(p.ws + WS_KH);
  const bf16_t* VT = (const bf16_t*)(p.ws + WS_VT);
  bf16_t* OUT = (bf16_t*)(p.ws + WS_YCAT);
  float* Oacc = (float*)smem;
  float* sm_m = Oacc + 8192;
  float* sm_l = sm_m + 128;
  const int qt = wave & 1, khf = wave >> 1;
  const int nk = seq < 16 ? 256 : 1280;
  const int ntile = nk >> 5, tpw = ntile >> 1;
  const bf16_t* vt = VT + ((size_t)kofs(seq) * 8 + (size_t)hd * nk) * 128;
  const bf16_t* kh = KH + ((size_t)kofs(seq) * 8 + (size_t)hd * nk) * 192;
  bf16_t* Qs = (bf16_t*)(sm_l + 128);
#pragma unroll
  for (int i = 0; i < 6; ++i) {
    const int idx = tid + i * 256, row = idx / 24, c8 = (idx % 24) * 8;
    *(uint4*)&Qs[row * 200 + c8] = *(const uint4*)(QB + (size_t)(qtok0 + row) * 1536 + hd * 192 + c8);
  }
  __syncthreads();
  const bf16_t* qs = Qs + (qt * 32 + l31) * 200 + lh * 8;
  f32x16 oacc[4];
#pragma unroll
  for (int dt = 0; dt < 4; ++dt)
#pragma unroll
    for (int r = 0; r < 16; ++r) oacc[dt][r] = 0.f;
  float mrun = -1e30f, lrun = 0.f;
#pragma unroll 1
  for (int kt = khf * tpw; kt < (khf + 1) * tpw; ++kt) {
    bf16x8 kf[12]; uint4 vf[8];
    const bf16_t* kn = kh + (size_t)kt * 6144 + lh * 256 + l31 * 8;
#pragma unroll
    for (int ks = 0; ks < 12; ++ks) kf[ks] = *(const bf16x8*)(kn + ks * 512);
    const bf16_t* vp = vt + (size_t)kt * 4096 + lh * 256 + l31 * 8;
#pragma unroll
    for (int dt = 0; dt < 4; ++dt) {
      vf[dt * 2] = *(const uint4*)(vp + (dt * 2 + 0) * 512); vf[dt * 2 + 1] = *(const uint4*)(vp + (dt * 2 + 1) * 512);
    }
    __builtin_amdgcn_sched_barrier(0);
    f32x16 s;
#pragma unroll
    for (int r = 0; r < 16; ++r) s[r] = 0.f;
#pragma unroll
    for (int ks = 0; ks < 12; ++ks) s = __builtin_amdgcn_mfma_f32_32x32x16_bf16(kf[ks], *(const bf16x8*)(qs + ks * 16), s, 0, 0, 0);
    float tmax = -1e30f;
#pragma unroll
    for (int r = 0; r < 16; ++r) { s[r] *= ATTN_SCALE; tmax = fmaxf(tmax, s[r]); }
    tmax = fmaxf(tmax, shx32(tmax, lane));
    const float mnew = fmaxf(mrun, tmax);
    const float alpha = expf(mrun - mnew);
    float ps = 0.f;
#pragma unroll
    for (int r = 0; r < 16; ++r) { s[r] = expf(s[r] - mnew); ps += s[r]; }
    ps += shx32(ps, lane);
    lrun = lrun * alpha + ps; mrun = mnew;
#pragma unroll
    for (int dt = 0; dt < 4; ++dt)
#pragma unroll
      for (int r = 0; r < 16; ++r) oacc[dt][r] *= alpha;
#pragma unroll
    for (int sh = 0; sh < 2; ++sh) {
      uint4 pw;
      pw.x = pk2(s[sh * 8 + 0], s[sh * 8 + 1]); pw.y = pk2(s[sh * 8 + 2], s[sh * 8 + 3]);
      pw.z = pk2(s[sh * 8 + 4], s[sh * 8 + 5]); pw.w = pk2(s[sh * 8 + 6], s[sh * 8 + 7]);
      const bf16x8 pf = __builtin_bit_cast(bf16x8, pw);
#pragma unroll
      for (int dt = 0; dt < 4; ++dt)
        oacc[dt] = __builtin_amdgcn_mfma_f32_32x32x16_bf16(__builtin_bit_cast(bf16x8, vf[dt * 2 + sh]), pf, oacc[dt], 0, 0, 0);
    }
  }
  for (int i = tid; i < 8192; i += 256) Oacc[i] = 0.f;
  if (lh == 0) { sm_m[wave * 32 + l31] = mrun; sm_l[wave * 32 + l31] = lrun; }
  __syncthreads();
  {
    const float m0 = sm_m[qt * 32 + l31], m1 = sm_m[(qt + 2) * 32 + l31];
    const float M = fmaxf(m0, m1);
    const float L = sm_l[qt * 32 + l31] * expf(m0 - M) + sm_l[(qt + 2) * 32 + l31] * expf(m1 - M);
    const float f = expf(mrun - M) / L;
    float* oq = Oacc + qt * 4096;
#pragma unroll
    for (int dt = 0; dt < 4; ++dt)
#pragma unroll
      for (int r = 0; r < 16; ++r) {
        const int d = dt * 32 + (r & 3) + 8 * (r >> 2) + 4 * lh;
        atomicAdd(&oq[d * 32 + l31], oacc[dt][r] * f);
      }
  }
  __syncthreads();
  {
    const int q = tid >> 2, dc = (tid & 3) * 32;
    const float* oq = Oacc + (q >> 5) * 4096 + (q & 31);
    bf16_t* dst = OUT + (size_t)(qtok0 + q) * DM + hd * 128 + dc;
#pragma unroll
    for (int h4 = 0; h4 < 4; ++h4) {
      float o[8];
#pragma unroll
      for (int i = 0; i < 8; ++i) o[i] = oq[(dc + h4 * 8 + i) * 32];
      uint4 w; w.x = pk2(o[0], o[1]); w.y = pk2(o[2], o[3]); w.z = pk2(o[4], o[5]); w.w = pk2(o[6], o[7]);
      *(uint4*)(dst + h4 * 8) = w;
    }
  }
  __syncthreads();
}
__device__ __forceinline__ void ph_attn(const C& p) {
  const int tid = p.tid;
  const int half = p.nb >> 1;
  if ((p.vb & 1) == 0) {
    for (int s_ = p.vb >> 1; s_ < 256; s_ += half) {
      const int b = s_ >> 7, hd = (s_ >> 4) & 7;
      attn_item(p, 16 + b, hd, NPR + b * 1024 + (s_ & 15) * 64, tid);
    }
  } else {
    for (int j = p.vb >> 1; j < 256; j += half) {
      for (int u = 0; u < 2; ++u) {
        const int i2 = j * 2 + u;
        const int b = i2 >> 5, hd = (i2 >> 2) & 7;
        attn_item(p, b, hd, b * 256 + (i2 & 3) * 64, tid);
      }
    }
  }
}

__device__ __forceinline__ void ph_final(const C& p) {
  const int tid = p.tid, lane = tid & 63, wave = tid >> 6;
  const float* X = (const float*)(p.ws + WS_XCUR);
  const float* g = p.in[35];
  for (int tok = p.bid * 4 + wave; tok < NTOK; tok += p.nb * 4) {
    const float* x = X + (size_t)tok * DM;
    float4 xv[4]; float ss = 0.f;
#pragma unroll
    for (int i = 0; i < 4; ++i) xv[i] = *(const float4*)(x + (i * 64 + lane) * 4);
    moe_combine_row(p, tok, 1, lane, xv);
#pragma unroll
    for (int i = 0; i < 4; ++i) ss += xv[i].x * xv[i].x + xv[i].y * xv[i].y + xv[i].z * xv[i].z + xv[i].w * xv[i].w;
    ss = wave_sum(ss, lane);
    const float rinv = rsqrtf(ss * (1.f / 1024.f) + RMS_EPS);
#pragma unroll
    for (int i = 0; i < 4; ++i) {
      const int d = (i * 64 + lane) * 4;
      const float4 gv = *(const float4*)(g + d);
      *(float4*)(p.out + O_Y + (size_t)tok * DM + d) = make_float4(xv[i].x * rinv * gv.x, xv[i].y * rinv * gv.y, xv[i].z * rinv * gv.z, xv[i].w * rinv * gv.w);
    }
  }
}

#define NPHASE 24
__device__ __forceinline__ void run_phase(const C& p, int ph) {
  switch (ph) {
    case 0: ph_ada(p); break;
    case 1: case 13: { const int L = ph == 13; ph_prep<false>(p, !L, p.in[9] + L * 1024, L, 0, nullptr); } break;
    case 2: ph_gemm_in0(p); break;
    case 3: ph_mix(p); break;
    case 4: ph_lora(p); break;
    case 5: ph_scan(p); break;
    case 6: ph_scanfix(p); break;
    case 7: ph_post(p); break;
    case 8: case 18: { const int L = ph == 18; ph_gemm_out(p, L ? p.in[30] : p.in[24], L, !L); } break;
    case 9: case 19: { const int L = ph == 19; ph_router(p, p.in[10] + L * 1024, L, p.in[31] + L * 1024 * 16); } break;
    case 10: case 20: ph_topk(p); break;
    case 11: case 21: ph_moe_up(p, ph == 21); break;
    case 12: case 22: ph_moe_down(p, ph == 22); break;
    case 14: ph_gemm_in1(p); break;
    case 15: ph_mla_norm(p); break;
    case 16: ph_mla_qkv(p); break;
    case 17: ph_attn(p); break;
    case 23: ph_final(p); break;
    default: break;
  }
}

__global__ void __launch_bounds__(256, 2) fwd_kernel(P p) {
  if (threadIdx.x == 0) xb_words = make_uint4(0u, 0u, 0u, 0u);
  __syncthreads();
  XcdBarrier bar = xcd_barrier_post((unsigned*)(p.ws + WS_BAR), (volatile LAS unsigned*)&xb_words);
  C c; (P&)c = p; c.nb = gridDim.x;
  const int wv_ = __builtin_amdgcn_readfirstlane(threadIdx.x >> 6);
#ifdef ONLY_PHASE
  c.tid = wv_ * 64 + (int)__builtin_amdgcn_mbcnt_hi(~0u, __builtin_amdgcn_mbcnt_lo(~0u, 0u)); c.bid = blockIdx.x; c.vb = (c.bid & 7) * (c.nb >> 3) + (c.bid >> 3);
  run_phase(c, ONLY_PHASE); xcd_barrier(bar);
#else
  for (int ph = p.ph_lo; ph < p.ph_hi; ++ph) {
    const int reps = (ph == p.probe_ph) ? p.probe_reps : 1;
    for (int r = 0; r < reps; ++r) {
      if (r) __syncthreads();
      int l_; asm volatile("v_mbcnt_lo_u32_b32 %0, -1, 0\n\tv_mbcnt_hi_u32_b32 %0, -1, %0" : "=v"(l_));
      int t_ = wv_ * 64 + l_, b_ = blockIdx.x; unsigned char* w_ = p.ws;
      asm volatile("" : "+v"(t_)); asm volatile("" : "+s"(b_)); asm volatile("" : "+s"(w_));
      c.tid = t_; c.bid = b_; c.ws = w_; c.vb = (b_ & 7) * (c.nb >> 3) + (b_ >> 3);
      run_phase(c, ph);
    }
    if (ph + 1 < p.ph_hi) xcd_barrier(bar);
  }
#endif
}

extern "C" void kernel_launch(void* const* d_in, const int* in_sizes, int n_in, void* d_out, int out_size, void* d_ws, size_t ws_size, hipStream_t stream) {
  static int grid = 0;
  if (grid == 0) {
    int dev = 0, cus = 0, per_cu = 0;
    hipGetDevice(&dev);
    hipDeviceGetAttribute(&cus, hipDeviceAttributeMultiprocessorCount, dev);
    hipOccupancyMaxActiveBlocksPerMultiprocessor(&per_cu, (const void*)fwd_kernel, 256, 0);
    (void)hipGetLastError();
    if (per_cu < 1) per_cu = 1;
    if (per_cu > 2) per_cu = 2;
    grid = cus * per_cu;
    grid &= ~7;
    if (grid < 8) grid = 8;
    if (ws_size < WS_END0) fprintf(stderr, "kernel_launch: workspace too small (%zu < %llu)\n", ws_size, (unsigned long long)WS_END0);
  }
  hipMemsetAsync((char*)d_ws + WS_BAR, 0, XCD_BAR_WORDS * 4, stream);
  P p{};
  for (int i = 0; i < 36; ++i) p.in[i] = (const float*)d_in[i];
  p.out = (float*)d_out; p.ws = (unsigned char*)d_ws;
  p.probe_ph = -1; p.probe_reps = 1;
#ifdef MULTI_LAUNCH
  for (int ph = 0; ph < NPHASE; ++ph) {
    p.ph_lo = ph; p.ph_hi = ph + 1;
    hipLaunchKernelGGL(fwd_kernel, dim3(grid), dim3(256), 0, stream, p);
  }
#else
  p.ph_lo = 0; p.ph_hi = NPHASE;
  hipLaunchKernelGGL(fwd_kernel, dim3(grid), dim3(256), 0, stream, p);
#endif
}
```

```cpp
#include <hip/hip_runtime.h>
#include <stdint.h>
#include <stdio.h>

typedef __attribute__((ext_vector_type(8))) short bf16x8;
typedef __attribute__((ext_vector_type(16))) float f32x16;
typedef unsigned short bf16_t;
typedef const __attribute__((address_space(4))) float cflt;
#define LAS __attribute__((address_space(3)))

#define NTOK 6144
#define NPR 4096
#define NSA 2048
#define DM 1024
#define IN0C 3456
#define ZMC 1920
#define IN1C 704
#define NKROW 6656
#define DECAY_SCALE 0.606531f
#define GN_EPS 64e-5f
#define RMS_EPS 1e-6f
#define ATTN_SCALE 0.07216878364870322f

#define WS_BAR   0ull
#define WS_MOD   (64ull << 10)
#define WS_ROPE  (WS_MOD + (256ull << 10))
#define WS_AFF   (WS_ROPE + (64ull << 10))
#define WS_IDX   (WS_AFF + (512ull << 10))
#define WS_GATE  (WS_IDX + (64ull << 10))
#define WS_H     (1ull << 20)
#define WS_YCAT  (WS_H + 12582912ull)
#define WS_XCUR  (WS_YCAT + 12582912ull)
#define WS_HID   (WS_XCUR + 25165824ull)
#define WS_Z     (WS_HID + 25165824ull)
#define WS_ZM    (WS_Z + 84934656ull)
#define WS_OPSA  (WS_ZM + 47185920ull)
#define WS_OPSB  (WS_OPSA + 25165824ull)
#define WS_GG    (WS_OPSB + 75497472ull)
#define WS_YD    (WS_GG + 12582912ull)
#define WS_UD    (WS_YD + 25165824ull)
#define WS_PQ    (WS_UD + 25165824ull)
#define WS_SEL   (WS_PQ + 25165824ull)
#define WS_END0  (WS_SEL + 393216ull)
#define WS_YE    WS_ZM
#define WS_Z1    WS_Z
#define WS_CQN   (WS_Z1 + 17301504ull)
#define WS_CKVN  (WS_CQN + 4718592ull)
#define WS_KPE   (WS_CKVN + 3407872ull)
#define WS_QBUF  (WS_KPE + 851968ull)
#define WS_KH    (WS_QBUF + 18874368ull)
#define WS_VT    (WS_KH + 20447232ull)

#define O_Y    0
#define O_ST   6291456
#define O_CKV  7340032
#define O_KPE  8388608

struct P {
  const float* in[36];
  float* out;
  unsigned char* ws;
  int ph_lo, ph_hi;
  int probe_ph, probe_reps;
};

struct C : P { int tid, bid, nb, vb; };

#define SMEM_BYTES 61440
__shared__ __attribute__((aligned(16))) unsigned char smem[SMEM_BYTES];
__shared__ uint4 xb_words;

__device__ __forceinline__ unsigned pk2(float lo, float hi) {
  typedef __attribute__((ext_vector_type(2))) __bf16 bf2;
  typedef __attribute__((ext_vector_type(2))) float fl2;
  fl2 f = {lo, hi};
  bf2 b = __builtin_convertvector(f, bf2);
  return __builtin_bit_cast(unsigned, b);
}
__device__ __forceinline__ bf16_t f2bf(float f) { return (bf16_t)(pk2(f, 0.f) & 0xffffu); }
__device__ __forceinline__ float bf2f(bf16_t b) { return __uint_as_float(((unsigned)b) << 16); }
__device__ __forceinline__ float sigmoidf_(float x) { return 1.f / (1.f + expf(-x)); }
__device__ __forceinline__ float fsigmoid_(float x) { return __builtin_amdgcn_rcpf(1.f + __builtin_amdgcn_exp2f(-1.4426950408889634f * x)); }
__device__ __forceinline__ float ftanh_(float x) { return 1.f - 2.f * __builtin_amdgcn_rcpf(1.f + __builtin_amdgcn_exp2f(2.8853900817779268f * x)); }
template <int M> __device__ __forceinline__ float swz(float v) {
  return __builtin_bit_cast(float, __builtin_amdgcn_ds_swizzle(__builtin_bit_cast(int, v), (M << 10) | 0x1f));
}
__device__ __forceinline__ float shx32(float v, int lane) {
  return __builtin_bit_cast(float, __builtin_amdgcn_ds_bpermute((lane ^ 32) << 2, __builtin_bit_cast(int, v)));
}
__device__ __forceinline__ float wave_sum(float v, int lane) {
  v += swz<1>(v); v += swz<2>(v); v += swz<4>(v); v += swz<8>(v); v += swz<16>(v); v += shx32(v, lane);
  return v;
}
__device__ __forceinline__ float4 ldg4(const float* base, unsigned off) { return *(const float4*)((const char*)base + (size_t)(off * 4u)); }
__device__ __forceinline__ int modrow(int tok) { return tok < NPR ? 0 : 1 + ((tok - NPR) >> 10); }

#define XB_TMO      128
#define XB_XCNT(j)  (256  + 64 * (j))
#define XB_XSUB(j)  (1280 + 64 * (j))
#define XB_XGEN(j)  (2304 + 64 * (j))
#define XB_TOP      3328
#define XB_TOPGEN   3392
#define XCD_BAR_WORDS 3456
#define XB_SPIN_CAP (1u << 20)
__device__ __forceinline__ unsigned xb_ld(unsigned* p)              { return __hip_atomic_load(p, __ATOMIC_RELAXED, __HIP_MEMORY_SCOPE_AGENT); }
__device__ __forceinline__ unsigned xb_add(unsigned* p, unsigned v) { return __hip_atomic_fetch_add(p, v, __ATOMIC_RELAXED, __HIP_MEMORY_SCOPE_AGENT); }
__device__ __forceinline__ unsigned xb_xcc_id() { return (unsigned)__builtin_amdgcn_s_getreg((3 << 11) | 20) & 0xFu; }
#define XB_SPIN(cond, bar) do { unsigned _sp = 0; while (cond) { __builtin_amdgcn_s_sleep(1); \
    if ((++_sp & 255u) == 0u) { if (xb_ld(&(bar)[XB_TMO])) break; if (_sp > XB_SPIN_CAP) { atomicAdd(&(bar)[XB_TMO], 1u); break; } } } } while (0)
struct XcdBarrier { unsigned* bar; unsigned x; volatile LAS unsigned* st; };
__device__ __forceinline__ XcdBarrier xcd_barrier_post(unsigned* bar, volatile LAS unsigned* st) {
  XcdBarrier b; b.bar = bar; b.x = xb_xcc_id(); b.st = st;
  if (threadIdx.x == 0) (void)xb_add(&bar[XB_XCNT(b.x)], 1u);
  return b;
}
__device__ __forceinline__ void xcd_barrier_complete(unsigned* bar, unsigned x, unsigned& nloc, unsigned& nx) {
  const unsigned G = gridDim.x * gridDim.y * gridDim.z;
  unsigned sum, cnt, mine, sp = 0u;
  for (;;) {
    sum = 0u; cnt = 0u; mine = 0u;
#pragma unroll
    for (unsigned j = 0; j < 16; ++j) { const unsigned c = xb_ld(&bar[XB_XCNT(j)]); sum += c; cnt += (c > 0u) ? 1u : 0u; mine = (j == x) ? c : mine; }
    if (sum == G) break;
    __builtin_amdgcn_s_sleep(1);
    if ((++sp & 255u) == 0u) { if (xb_ld(&bar[XB_TMO])) break; if (sp > XB_SPIN_CAP) { atomicAdd(&bar[XB_TMO], 1u); break; } }
  }
  nloc = mine > 0u ? mine : 1u; nx = cnt > 0u ? cnt : 1u;
}
__device__ __forceinline__ void xcd_barrier(const XcdBarrier& b) {
  asm volatile("s_waitcnt vmcnt(0)" ::: "memory");
  __syncthreads();
  if (threadIdx.x == 0) {
    unsigned* bar = b.bar;
    __builtin_amdgcn_s_waitcnt(0);
    unsigned nloc = b.st[0], nx = b.st[1];
    if (nloc == 0u) { xcd_barrier_complete(bar, b.x, nloc, nx); b.st[0] = nloc; b.st[1] = nx; }
    const unsigned old = xb_add(&bar[XB_XSUB(b.x)], 1u);
    const unsigned gen = old / nloc;
    if (old + 1u == (gen + 1u) * nloc) {
      __builtin_amdgcn_fence(__ATOMIC_RELEASE, "agent");
      asm volatile("s_waitcnt vmcnt(0)" ::: "memory");
      const unsigned og = xb_add(&bar[XB_TOP], 1u);
      const unsigned tg = og / nx;
      if (og + 1u == (tg + 1u) * nx) xb_add(&bar[XB_TOPGEN], 1u);
      else XB_SPIN(xb_ld(&bar[XB_TOPGEN]) == tg, bar);
      __builtin_amdgcn_fence(__ATOMIC_ACQUIRE, "agent");
      xb_add(&bar[XB_XGEN(b.x)], 1u);
      asm volatile("s_waitcnt vmcnt(0)" ::: "memory");
    } else {
      XB_SPIN(xb_ld(&bar[XB_XGEN(b.x)]) == gen, bar);
      __builtin_amdgcn_fence(__ATOMIC_ACQUIRE, "agent");
      asm volatile("s_waitcnt vmcnt(0)" ::: "memory");
    }
  }
  __syncthreads();
}

#define LDS_S 72
template <int NB, bool PAIR, class AL, class BL, class EP>
__device__ __forceinline__ void gemm_core(int tid_, int K, AL al, BL bl, EP ep) {
  bf16_t* As = (bf16_t*)smem;
  bf16_t* Bs = As + 128 * LDS_S;
  const int tid = tid_, lane = tid & 63, wave = tid >> 6;
  const int wm = wave >> 1, wn = wave & 1, l31 = lane & 31, lh = lane >> 5;
  f32x16 acc[NB][2][2];
#pragma unroll
  for (int b = 0; b < NB; ++b)
#pragma unroll
    for (int i = 0; i < 2; ++i)
#pragma unroll
      for (int j = 0; j < 2; ++j)
#pragma unroll
        for (int r = 0; r < 16; ++r) acc[b][i][j][r] = 0.f;
  const int arow = tid >> 1, akb = (tid & 1) * 32;
  const int bng = (tid & 31) * 4, bkg = (tid >> 5) * 8;
  uint4 ra[4]; float4 rb[2][8];
#pragma unroll
  for (int i = 0; i < 4; ++i) ra[i] = al(arow, akb + i * 8);
#pragma unroll
  for (int i = 0; i < 8; ++i) rb[0][i] = bl(0, bkg + i, bng);
  if (K > 64) {
#pragma unroll
    for (int i = 0; i < 8; ++i) rb[1][i] = bl(0, 64 + bkg + i, bng);
  }
#pragma unroll 1
  for (int kbase = 0; kbase < K; kbase += 128) {
#pragma unroll
  for (int hb = 0; hb < 2; ++hb) {
    const int k0 = kbase + hb * 64;
    if (k0 < K) {
#pragma unroll
    for (int i = 0; i < 4; ++i) *(uint4*)&As[arow * LDS_S + akb + i * 8] = ra[i];
#pragma unroll
    for (int j = 0; j < 4; ++j) {
      uint4 w;
      w.x = pk2(((const float*)&rb[hb][0])[j], ((const float*)&rb[hb][1])[j]);
      w.y = pk2(((const float*)&rb[hb][2])[j], ((const float*)&rb[hb][3])[j]);
      w.z = pk2(((const float*)&rb[hb][4])[j], ((const float*)&rb[hb][5])[j]);
      w.w = pk2(((const float*)&rb[hb][6])[j], ((const float*)&rb[hb][7])[j]);
      *(uint4*)&Bs[(bng + j) * LDS_S + bkg] = w;
    }
    __syncthreads();
    if (k0 + 64 < K) {
#pragma unroll
      for (int i = 0; i < 4; ++i) ra[i] = al(arow, k0 + 64 + akb + i * 8);
    }
    if (k0 + 128 < K) {
#pragma unroll
      for (int i = 0; i < 8; ++i) rb[hb][i] = bl(0, k0 + 128 + bkg + i, bng);
    }
#pragma unroll
    for (int ks = 0; ks < 4; ++ks) {
      bf16x8 af[2], bfr[2];
#pragma unroll
      for (int mt = 0; mt < 2; ++mt) af[mt] = *(const bf16x8*)&As[(wm * 64 + mt * 32 + l31) * LDS_S + ks * 16 + lh * 8];
#pragma unroll
      for (int nt = 0; nt < 2; ++nt) bfr[nt] = *(const bf16x8*)&Bs[(wn * 64 + nt * 32 + l31) * LDS_S + ks * 16 + lh * 8];
#pragma unroll
      for (int mt = 0; mt < 2; ++mt)
#pragma unroll
        for (int nt = 0; nt < 2; ++nt) acc[0][mt][nt] = __builtin_amdgcn_mfma_f32_32x32x16_bf16(af[mt], bfr[nt], acc[0][mt][nt], 0, 0, 0);
    }
    __syncthreads();
    }
  }
  }
  int eM = wm * 64 + lh * 4, eN = l31;
  asm volatile("" : "+v"(eM), "+v"(eN));
  if constexpr (PAIR) {
#pragma unroll
    for (int mt = 0; mt < 2; ++mt)
#pragma unroll
      for (int rg = 0; rg < 4; ++rg) {
        float v[2][4];
#pragma unroll
        for (int i = 0; i < 4; ++i) { v[0][i] = acc[0][mt][0][rg * 4 + i]; v[1][i] = acc[0][mt][1][rg * 4 + i]; }
        ep(eM + mt * 32 + rg * 8, wn * 32 + eN, v);
      }
  } else {
#pragma unroll
    for (int mt = 0; mt < 2; ++mt)
#pragma unroll
      for (int nt = 0; nt < 2; ++nt)
#pragma unroll
        for (int rg = 0; rg < 4; ++rg) {
          float v[NB][4];
#pragma unroll
          for (int b = 0; b < NB; ++b)
#pragma unroll
            for (int i = 0; i < 4; ++i) v[b][i] = acc[b][mt][nt][rg * 4 + i];
          ep(eM + mt * 32 + rg * 8, wn * 64 + nt * 32 + eN, v);
        }
  }
}
template <int NB, class AL, class BL, class EP>
__device__ __forceinline__ void gemm_tile(int tid_, int K, AL al, BL bl, EP ep) { gemm_core<NB, false>(tid_, K, al, bl, ep); }

__device__ __forceinline__ void tile_mn(int T, int Mt, int Nt, int& mt, int& nt) {
  const int g = T / (Mt * 4), rem = T - g * Mt * 4;
  const int gs = (Nt - 4 * g) < 4 ? (Nt - 4 * g) : 4;
  mt = rem / gs; nt = 4 * g + rem % gs;
}

__device__ __forceinline__ void ada_range(const C& p, int t_first, int t_step, int t_end) {
  const int tid = p.tid;
  float* sc = (float*)smem;
  float* red = sc + 3072;
  const float* cc = p.in[5]; const float* cctx = p.in[6];
  for (int i = tid; i < 3072; i += 256) {
    int r = i >> 10, k = i & 1023;
    float c = (r == 0) ? cctx[k] : cc[(r - 1) * 1024 + k];
    sc[i] = c / (1.f + expf(-c));
  }
  __syncthreads();
  float* mod = (float*)(p.ws + WS_MOD);
  for (int t = t_first; t < t_end; t += t_step) {
    const int layer = t / 192, c0 = (t % 192) * 32;
    const int cg = tid & 7, kg = tid >> 3;
    const float* W = p.in[7] + (size_t)layer * 1024 * 6144 + c0 + cg * 4;
    float a[3][4];
#pragma unroll
    for (int r = 0; r < 3; ++r)
#pragma unroll
      for (int j = 0; j < 4; ++j) a[r][j] = 0.f;
#pragma unroll 8
    for (int kk = 0; kk < 32; ++kk) {
      const int k = kg * 32 + kk;
      const float4 w = *(const float4*)(W + (size_t)k * 6144);
#pragma unroll
      for (int r = 0; r < 3; ++r) {
        const float s = sc[r * 1024 + k];
        a[r][0] += s * w.x; a[r][1] += s * w.y; a[r][2] += s * w.z; a[r][3] += s * w.w;
      }
    }
#pragma unroll
    for (int r = 0; r < 3; ++r)
#pragma unroll
      for (int j = 0; j < 4; ++j) red[(kg * 3 + r) * 32 + cg * 4 + j] = a[r][j];
    __syncthreads();
    if (tid < 96) {
      const int r = tid >> 5, c = tid & 31;
      float s = 0.f;
#pragma unroll
      for (int g = 0; g < 32; ++g) s += red[(g * 3 + r) * 32 + c];
      mod[(size_t)(layer * 3 + r) * 6144 + c0 + c] = s + p.in[8][layer * 6144 + c0 + c];
    }
    __syncthreads();
  }
}
__device__ __forceinline__ void ph_ada(const C& p) {
  const int tid = p.tid;
  ada_range(p, p.bid, p.nb, p.nb > 384 ? 192 : 384);
  if (p.bid == p.nb - 1) {
    float* tab = (float*)(p.ws + WS_ROPE);
    for (int i = tid; i < 1024; i += 256) {
      const int pos = i >> 4, f = i & 15;
      const float ang = (float)pos * powf(10000.f, -(float)f / 16.f);
      tab[i * 2] = cosf(ang); tab[i * 2 + 1] = sinf(ang);
    }
  }
}

__device__ __forceinline__ void moe_combine_row(const C& p, int tok, int ml, int lane, float4 (&xv)[4]) {
  const int* SEL = (const int*)(p.ws + WS_SEL);
  const float* aff = (const float*)(p.ws + WS_AFF);
  const float* mod = (const float*)(p.ws + WS_MOD);
  const bf16_t* YE = (const bf16_t*)(p.ws + WS_YE);
  const int grp = tok >= NPR, nloc = tok - grp * NPR;
  float4 acc[4];
#pragma unroll
  for (int i = 0; i < 4; ++i) acc[i] = make_float4(0.f, 0.f, 0.f, 0.f);
  int sl[16]; float gts[16];
#pragma unroll
  for (int q = 0; q < 4; ++q) { const int4 v = *(const int4*)(SEL + tok * 16 + q * 4); sl[q * 4] = v.x; sl[q * 4 + 1] = v.y; sl[q * 4 + 2] = v.z; sl[q * 4 + 3] = v.w; }
#pragma unroll
  for (int e = 0; e < 16; ++e) gts[e] = aff[(size_t)(grp * 16 + e) * 4096 + nloc];
#pragma unroll
  for (int e = 0; e < 16; ++e) {
    const int slot = sl[e];
    if (slot >= 0) {
      const float gt = gts[e];
      const bf16_t* ye = YE + (size_t)(e * 768 + slot) * 1024;
#pragma unroll
      for (int i = 0; i < 4; ++i) {
        const uint2 w = *(const uint2*)(ye + (i * 64 + lane) * 4);
        acc[i].x += gt * __uint_as_float(w.x << 16); acc[i].y += gt * __uint_as_float(w.x & 0xffff0000u);
        acc[i].z += gt * __uint_as_float(w.y << 16); acc[i].w += gt * __uint_as_float(w.y & 0xffff0000u);
      }
    }
  }
  const float* g5 = mod + (size_t)(ml * 3 + modrow(tok)) * 6144 + 5 * 1024;
#pragma unroll
  for (int i = 0; i < 4; ++i) {
    const float4 gv = *(const float4*)(g5 + (i * 64 + lane) * 4);
    xv[i].x += gv.x * acc[i].x; xv[i].y += gv.y * acc[i].y; xv[i].z += gv.z * acc[i].z; xv[i].w += gv.w * acc[i].w;
  }
}

template <bool ROUTER>
__device__ __forceinline__ void ph_prep(const C& p, bool from_inputs, const float* g, int layer, int slot_shift, const float* rw) {
  const int tid = p.tid, lane = tid & 63, wave = tid >> 6;
  const float* mod = (const float*)(p.ws + WS_MOD);
  const float* xcur = (const float*)(p.ws + WS_XCUR);
  bf16_t* H = (bf16_t*)(p.ws + WS_H);
  float* aff = (float*)(p.ws + WS_AFF);
  for (int tok = p.bid * 4 + wave; tok < NTOK; tok += p.nb * 4) {
    const float* x = from_inputs ? (tok < NPR ? p.in[0] + (size_t)tok * DM : p.in[1] + (size_t)(tok - NPR) * DM) : xcur + (size_t)tok * DM;
    const int mr = modrow(tok);
    const float* sh = mod + (size_t)(layer * 3 + mr) * 6144 + slot_shift * 1024;
    const float* scl = sh + 1024;
    float4 xv[4];
    float ss = 0.f;
#pragma unroll
    for (int i = 0; i < 4; ++i) xv[i] = *(const float4*)(x + (i * 64 + lane) * 4);
    if (!ROUTER && !from_inputs) {
      moe_combine_row(p, tok, 0, lane, xv);
      float* xw = (float*)(p.ws + WS_XCUR) + (size_t)tok * DM;
#pragma unroll
      for (int i = 0; i < 4; ++i) *(float4*)(xw + (i * 64 + lane) * 4) = xv[i];
    }
    if (ROUTER) { if (lane < 16) ((int*)(p.ws + WS_SEL))[tok * 16 + lane] = -1; }
#pragma unroll
    for (int i = 0; i < 4; ++i) ss += xv[i].x * xv[i].x + xv[i].y * xv[i].y + xv[i].z * xv[i].z + xv[i].w * xv[i].w;
    ss = wave_sum(ss, lane);
    const float rinv = rsqrtf(ss * (1.f / 1024.f) + RMS_EPS);
    float lg[16];
    if (ROUTER) {
#pragma unroll
      for (int e = 0; e < 16; ++e) lg[e] = 0.f;
    }
#pragma unroll
    for (int i = 0; i < 4; ++i) {
      const int d = (i * 64 + lane) * 4;
      const float4 gv = *(const float4*)(g + d), sv = *(const float4*)(sh + d), cv = *(const float4*)(scl + d);
      float h[4];
      h[0] = xv[i].x * rinv * gv.x * (1.f + cv.x) + sv.x;
      h[1] = xv[i].y * rinv * gv.y * (1.f + cv.y) + sv.y;
      h[2] = xv[i].z * rinv * gv.z * (1.f + cv.z) + sv.z;
      h[3] = xv[i].w * rinv * gv.w * (1.f + cv.w) + sv.w;
      uint2 o; o.x = pk2(h[0], h[1]); o.y = pk2(h[2], h[3]);
      *(uint2*)(H + (size_t)tok * DM + d) = o;
      if (ROUTER) {
#pragma unroll
        for (int j = 0; j < 4; ++j) {
          const float4* rr = (const float4*)(rw + (size_t)(d + j) * 16);
#pragma unroll
          for (int q = 0; q < 4; ++q) {
            const float4 w = rr[q];
            lg[q * 4 + 0] += h[j] * w.x; lg[q * 4 + 1] += h[j] * w.y; lg[q * 4 + 2] += h[j] * w.z; lg[q * 4 + 3] += h[j] * w.w;
          }
        }
      }
    }
    if (ROUTER) {
      float mx = -1e30f;
#pragma unroll
      for (int e = 0; e < 16; ++e) { lg[e] = wave_sum(lg[e], lane); mx = fmaxf(mx, lg[e]); }
      float se = 0.f;
#pragma unroll
      for (int e = 0; e < 16; ++e) { lg[e] = expf(lg[e] - mx); se += lg[e]; }
      const float inv = 1.f / se;
      const int grp = tok >= NPR, nloc = tok - grp * NPR;
      float mine = 0.f;
#pragma unroll
      for (int e = 0; e < 16; ++e) mine = (lane == e) ? lg[e] * inv : mine;
      if (lane < 16) aff[(size_t)(grp * 16 + lane) * 4096 + nloc] = mine;
    }
  }
}

__device__ __forceinline__ void ph_router(const C& p, const float* g, int layer, const float* rw) {
  const int tid = p.tid, lane = tid & 63, wave = tid >> 6;
  const float* mod = (const float*)(p.ws + WS_MOD);
  const float* xcur = (const float*)(p.ws + WS_XCUR);
  bf16_t* H = (bf16_t*)(p.ws + WS_H);
  float* aff = (float*)(p.ws + WS_AFF);
  int* SEL = (int*)(p.ws + WS_SEL);
  for (int base = (p.bid * 4 + wave) * 3; base < NTOK; base += p.nb * 12) {
    float rinv[3]; const float* sh[3];
#pragma unroll
    for (int j = 0; j < 3; ++j) {
      const int tok = base + j;
      const float* x = xcur + (size_t)tok * DM;
      float ss = 0.f;
#pragma unroll
      for (int i = 0; i < 4; ++i) { const float4 v = *(const float4*)(x + (i * 64 + lane) * 4); ss += v.x * v.x + v.y * v.y + v.z * v.z + v.w * v.w; }
      ss = wave_sum(ss, lane);
      rinv[j] = rsqrtf(ss * (1.f / 1024.f) + RMS_EPS);
      sh[j] = mod + (size_t)(layer * 3 + modrow(tok)) * 6144 + 3 * 1024;
      if (lane < 16) SEL[tok * 16 + lane] = -1;
    }
    float lg[3][16];
#pragma unroll
    for (int j = 0; j < 3; ++j)
#pragma unroll
      for (int e = 0; e < 16; ++e) lg[j][e] = 0.f;
#pragma unroll 1
    for (int i = 0; i < 4; ++i) {
      const int d = (i * 64 + lane) * 4;
      const float4 gv = *(const float4*)(g + d);
      float h[3][4];
#pragma unroll
      for (int j = 0; j < 3; ++j) {
        const float4 xq = *(const float4*)(xcur + (size_t)(base + j) * DM + d);
        const float4 sv = *(const float4*)(sh[j] + d), cv = *(const float4*)(sh[j] + 1024 + d);
        h[j][0] = xq.x * rinv[j] * gv.x * (1.f + cv.x) + sv.x;
        h[j][1] = xq.y * rinv[j] * gv.y * (1.f + cv.y) + sv.y;
        h[j][2] = xq.z * rinv[j] * gv.z * (1.f + cv.z) + sv.z;
        h[j][3] = xq.w * rinv[j] * gv.w * (1.f + cv.w) + sv.w;
        uint2 o; o.x = pk2(h[j][0], h[j][1]); o.y = pk2(h[j][2], h[j][3]);
        *(uint2*)(H + (size_t)(base + j) * DM + d) = o;
      }
#pragma unroll
      for (int jj = 0; jj < 4; ++jj) {
        const float4* rr = (const float4*)(rw + (size_t)(d + jj) * 16);
#pragma unroll
        for (int q = 0; q < 4; ++q) {
          const float4 w = rr[q];
#pragma unroll
          for (int j = 0; j < 3; ++j) {
            lg[j][q * 4 + 0] += h[j][jj] * w.x; lg[j][q * 4 + 1] += h[j][jj] * w.y; lg[j][q * 4 + 2] += h[j][jj] * w.z; lg[j][q * 4 + 3] += h[j][jj] * w.w;
          }
        }
      }
    }
#pragma unroll
    for (int j = 0; j < 3; ++j) {
      const int tok = base + j;
      float mx = -1e30f;
#pragma unroll
      for (int e = 0; e < 16; ++e) { lg[j][e] = wave_sum(lg[j][e], lane); mx = fmaxf(mx, lg[j][e]); }
      float se = 0.f;
#pragma unroll
      for (int e = 0; e < 16; ++e) { lg[j][e] = expf(lg[j][e] - mx); se += lg[j][e]; }
      const float inv = 1.f / se;
      const int grp = tok >= NPR, nloc = tok - grp * NPR;
      float mine = 0.f;
#pragma unroll
      for (int e = 0; e < 16; ++e) mine = (lane == e) ? lg[j][e] * inv : mine;
      if (lane < 16) aff[(size_t)(grp * 16 + lane) * 4096 + nloc] = mine;
    }
  }
}

__device__ __forceinline__ void ph_gemm_in0(const C& p) {
  const bf16_t* H = (const bf16_t*)(p.ws + WS_H);
  const float* W = p.in[11];
  float* Z = (float*)(p.ws + WS_Z);
  for (int t = p.vb; t < 48 * 27; t += p.nb) {
    int mt_, nt_; tile_mn(t, 48, 27, mt_, nt_);
    const int m0 = mt_ * 128, n0 = nt_ * 128;
    gemm_tile<1>(p.tid, 1024,
      [=](int m, int k) { return *(const uint4*)(H + (size_t)(m0 + m) * DM + k); },
      [=](int, int k, int n) { return ldg4(W, (unsigned)(k * IN0C + n0 + n)); },
      [=](int m, int n, const float (&v)[1][4]) {
#pragma unroll
        for (int i = 0; i < 4; ++i) Z[(size_t)(m0 + m + i) * IN0C + n0 + n] = v[0][i];
      });
  }
}

__device__ __forceinline__ void ph_mix(const C& p) {
  const int tid = p.tid, lane = tid & 63, wave = tid >> 6;
  const float* Z = (const float*)(p.ws + WS_Z);
  float* ZM = (float*)(p.ws + WS_ZM);
  float* OA = (float*)(p.ws + WS_OPSA);
  bf16_t* YC = (bf16_t*)(p.ws + WS_YCAT);
  const float* cw = p.in[12]; const float* mu = p.in[13]; const float* kk_w = p.in[19];
  for (int tok = p.bid * 4 + wave; tok < NTOK; tok += p.nb * 4) {
    int t, T;
    if (tok < NPR) { t = tok & 255; T = 256; } else { t = (tok - NPR) & 1023; T = 1024; }
    const bool hasL = t > 0, hasR = t < T - 1;
    const float* zc = Z + (size_t)tok * IN0C;
    const float* zl = zc - IN0C; const float* zr = zc + IN0C;
    {
      const int c = lane * 8;
      float o[8];
#pragma unroll
      for (int q = 0; q < 2; ++q) {
        const int cq = c + q * 4;
        const float4 gb = *(const float4*)(zc + cq);
        const float4 gc = *(const float4*)(zc + 512 + cq), xa = *(const float4*)(zc + 1024 + cq);
        float4 ul = make_float4(0.f, 0.f, 0.f, 0.f), ur = ul;
        if (hasL) { const float4 a = *(const float4*)(zl + 512 + cq), b = *(const float4*)(zl + 1024 + cq); ul = make_float4(a.x * b.x, a.y * b.y, a.z * b.z, a.w * b.w); }
        if (hasR) { const float4 a = *(const float4*)(zr + 512 + cq), b = *(const float4*)(zr + 1024 + cq); ur = make_float4(a.x * b.x, a.y * b.y, a.z * b.z, a.w * b.w); }
        const float4 w0 = *(const float4*)(cw + cq), w1 = *(const float4*)(cw + 512 + cq), w2 = *(const float4*)(cw + 1024 + cq);
        o[q * 4 + 0] = gb.x * (w0.x * ul.x + w1.x * gc.x * xa.x + w2.x * ur.x);
        o[q * 4 + 1] = gb.y * (w0.y * ul.y + w1.y * gc.y * xa.y + w2.y * ur.y);
        o[q * 4 + 2] = gb.z * (w0.z * ul.z + w1.z * gc.z * xa.z + w2.z * ur.z);
        o[q * 4 + 3] = gb.w * (w0.w * ul.w + w1.w * gc.w * xa.w + w2.w * ur.w);
      }
      uint4 w; w.x = pk2(o[0], o[1]); w.y = pk2(o[2], o[3]); w.z = pk2(o[4], o[5]); w.w = pk2(o[6], o[7]);
      *(uint4*)(YC + (size_t)tok * DM + c) = w;
    }
#pragma unroll
    for (int i = 0; i < 8; ++i) {
      const int c = i * 256 + lane * 4;
      if (c < ZMC) {
        const float4 a = *(const float4*)(zc + 1536 + c);
        float4 l = make_float4(0.f, 0.f, 0.f, 0.f), r = l;
        if (hasL) l = *(const float4*)(zl + 1536 + c);
        if (hasR) r = *(const float4*)(zr + 1536 + c);
        const float4 m = *(const float4*)(mu + c);
        float4 o;
        o.x = a.x + m.x * (0.5f * (l.x + r.x) - a.x);
        o.y = a.y + m.y * (0.5f * (l.y + r.y) - a.y);
        o.z = a.z + m.z * (0.5f * (l.z + r.z) - a.z);
        o.w = a.w + m.w * (0.5f * (l.w + r.w) - a.w);
        *(float4*)(ZM + (size_t)tok * ZMC + c) = o;
        if (i < 2) {
          const int h = c >> 6, j = c & 63;
          *(float4*)(OA + ((size_t)(tok * 8 + h) * 2 + 1) * 64 + j) = o;
        } else if (i < 4) {
          const int ck = c - 512;
          const float4 kw = *(const float4*)(kk_w + ck);
          float4 q = make_float4(o.x * kw.x, o.y * kw.y, o.z * kw.z, o.w * kw.w);
          float ss = q.x * q.x + q.y * q.y + q.z * q.z + q.w * q.w;
          ss += swz<1>(ss); ss += swz<2>(ss); ss += swz<4>(ss); ss += swz<8>(ss);
          const float rn = -rsqrtf(fmaxf(ss, 1e-12f));
          q.x *= rn; q.y *= rn; q.z *= rn; q.w *= rn;
          const int h = ck >> 6, j = ck & 63;
          *(float4*)(OA + ((size_t)(tok * 8 + h) * 2 + 0) * 64 + j) = q;
        }
      }
    }
  }
}

__device__ __forceinline__ void ph_lora(const C& p) {
  const float* ZM = (const float*)(p.ws + WS_ZM);
  const float* OA = (const float*)(p.ws + WS_OPSA);
  float* OB = (float*)(p.ws + WS_OPSB);
  float* GG = (float*)(p.ws + WS_GG);
  for (int t = p.vb; t < 960; t += p.nb) {
    const int g = t / 192, rem = t % 192;
    const int m0 = (rem >> 2) * 128, n0 = (rem & 3) * 128;
    if (g < 2) {
      const int d = g;
      const float* W = p.in[15] + (size_t)d * 64 * 512;
      const float* w0 = p.in[14] + d * 512;
      gemm_tile<1>(p.tid, 64,
        [=](int m, int k) {
          const float* s = ZM + (size_t)(m0 + m) * ZMC + 1536 + d * 64 + k;
          const float4 a = *(const float4*)s, b = *(const float4*)(s + 4);
          uint4 o; o.x = pk2(ftanh_(a.x), ftanh_(a.y)); o.y = pk2(ftanh_(a.z), ftanh_(a.w)); o.z = pk2(ftanh_(b.x), ftanh_(b.y)); o.w = pk2(ftanh_(b.z), ftanh_(b.w));
          return o; },
        [=](int, int k, int n) { return ldg4(W, (unsigned)(k * 512 + n0 + n)); },
        [=](int m, int n, const float (&v)[1][4]) {
          const int nn = n0 + n, h = nn >> 6, j = nn & 63;
          const float b0 = w0[nn];
#pragma unroll
          for (int i = 0; i < 4; ++i) {
            const int tok = m0 + m + i;
            OB[(((size_t)d * NTOK + tok) * 8 + h) * 192 + j] = __builtin_amdgcn_exp2f((-DECAY_SCALE * 1.4426950408889634f) * fsigmoid_(b0 + v[0][i]));
          }
        });
    } else if (g < 4) {
      const int d = g - 2;
      const float* W = p.in[17] + (size_t)d * 64 * 512;
      const float* a0 = p.in[16] + d * 512;
      const float* ka = p.in[20];
      gemm_tile<1>(p.tid, 64,
        [=](int m, int k) {
          const float* s = ZM + (size_t)(m0 + m) * ZMC + 1664 + d * 64 + k;
          const float4 a = *(const float4*)s, b = *(const float4*)(s + 4);
          uint4 o; o.x = pk2(a.x, a.y); o.y = pk2(a.z, a.w); o.z = pk2(b.x, b.y); o.w = pk2(b.z, b.w);
          return o; },
        [=](int, int k, int n) { return ldg4(W, (unsigned)(k * 512 + n0 + n)); },
        [=](int m, int n, const float (&v)[1][4]) {
          const int nn = n0 + n, h = nn >> 6, j = nn & 63;
          const float b0 = a0[nn];
#pragma unroll
          for (int i = 0; i < 4; ++i) {
            const int tok = m0 + m + i;
            OB[(((size_t)d * NTOK + tok) * 8 + h) * 192 + 64 + j] = fsigmoid_(b0 + v[0][i]);
          }
        });
    } else {
      const float* W = p.in[18];
      gemm_tile<1>(p.tid, 128,
        [=](int m, int k) {
          const float* s = ZM + (size_t)(m0 + m) * ZMC + 1792 + k;
          const float4 a = *(const float4*)s, b = *(const float4*)(s + 4);
          uint4 o; o.x = pk2(fsigmoid_(a.x), fsigmoid_(a.y)); o.y = pk2(fsigmoid_(a.z), fsigmoid_(a.w)); o.z = pk2(fsigmoid_(b.x), fsigmoid_(b.y)); o.w = pk2(fsigmoid_(b.z), fsigmoid_(b.w));
          return o; },
        [=](int, int k, int n) { return ldg4(W, (unsigned)(k * 512 + n0 + n)); },
        [=](int m, int n, const float (&v)[1][4]) {
#pragma unroll
          for (int i = 0; i < 4; ++i) GG[(size_t)(m0 + m + i) * 512 + n0 + n] = v[0][i];
        });
    }
  }
}

#define CH_L 128
__device__ __forceinline__ int pq_entry(int ch, int c) { return ch < 32 ? ch * 8 + c : 256 + (ch - 32) * 2 + c; }
__device__ __forceinline__ void ph_scan(const C& p) {
  const int lane = p.tid & 63;
  const int wave = __builtin_amdgcn_readfirstlane(p.tid >> 6);
  const float* ZM = (const float*)(p.ws + WS_ZM);
  const float* OA = (const float*)(p.ws + WS_OPSA);
  const float* OB = (const float*)(p.ws + WS_OPSB);
  float* YD = (float*)(p.ws + WS_YD);
  float* UD = (float*)(p.ws + WS_UD);
  float* PQ = (float*)(p.ws + WS_PQ);
  const int d = wave >> 1, ident = wave & 1;
  for (int it = p.bid; it < 384; it += p.nb) {
    int b, h, c, T, tok0, ch;
    if (it < 128) { b = it >> 6; h = (it >> 3) & 7; c = it & 7; T = 1024; tok0 = NPR + b * 1024; ch = (b * 8 + h) * 2 + d; }
    else { const int i2 = it - 128; b = i2 >> 4; h = (i2 >> 1) & 7; c = i2 & 1; T = 256; tok0 = b * 256; ch = 32 + (b * 8 + h) * 2 + d; }
    if (ident && c == 0) continue;
    float S[64];
    if (ident) {
#pragma unroll
      for (int k = 0; k < 64; ++k) S[k] = (k == lane) ? 1.f : 0.f;
    } else if (c == 0 && it < 128) {
      const float* s0 = p.in[2] + ((size_t)((b * 2 + d) * 8 + h) * 64 + lane) * 64;
#pragma unroll
      for (int k = 0; k < 64; k += 4) { const float4 v = *(const float4*)(s0 + k); S[k] = v.x; S[k + 1] = v.y; S[k + 2] = v.z; S[k + 3] = v.w; }
    } else {
#pragma unroll
      for (int k = 0; k < 64; ++k) S[k] = 0.f;
    }
    const int tinc = d ? -1 : 1;
    const int tokA = tok0 + (d ? T - 1 - c * CH_L : c * CH_L);
    float* yout = ident ? UD : YD;
    float ob[4][5], vb[4];
    const float ka_l = p.in[20][h * 64 + lane];
    auto fetch = [&](int j, int sidx) {
      const int sc = sidx < CH_L ? sidx : CH_L - 1;
      const int tk = tokA + sc * tinc;
      const float* pa = OA + (size_t)(tk * 8 + h) * 128 + lane;
      const float* pb = OB + (((size_t)d * NTOK + tk) * 8 + h) * 192 + lane;
      const float nk_ = pa[0], a_ = pb[64], kp_ = ZM[(size_t)tk * ZMC + 512 + h * 64 + lane];
      ob[j][0] = nk_; ob[j][1] = pa[64]; ob[j][2] = pb[0];
      ob[j][3] = -nk_ * a_;
      ob[j][4] = kp_ * (1.f + (a_ - 1.f) * ka_l);
      vb[j] = ident ? 0.f : ZM[(size_t)tk * ZMC + 1024 + h * 64 + lane];
    };
#pragma unroll
    for (int j = 0; j < 4; ++j) fetch(j, j);
#pragma unroll 1
    for (int s0 = 0; s0 < CH_L; s0 += 4) {
#pragma unroll
      for (int j = 0; j < 4; ++j) {
        const int tok = tokA + (s0 + j) * tinc;
        const int i_nkk = __builtin_bit_cast(int, ob[j][0]), i_r = __builtin_bit_cast(int, ob[j][1]);
        const int i_w = __builtin_bit_cast(int, ob[j][2]), i_b = __builtin_bit_cast(int, ob[j][3]), i_kd = __builtin_bit_cast(int, ob[j][4]);
        const float vv = vb[j];
        float sa0 = 0.f, sa1 = 0.f;
#pragma unroll
        for (int k = 0; k < 64; k += 2) {
          sa0 += S[k] * __builtin_bit_cast(float, __builtin_amdgcn_readlane(i_nkk, k));
          sa1 += S[k + 1] * __builtin_bit_cast(float, __builtin_amdgcn_readlane(i_nkk, k + 1));
        }
        const float sa = sa0 + sa1;
        float y0 = 0.f, y1 = 0.f;
#pragma unroll
        for (int k = 0; k < 64; k += 2) {
          S[k] = S[k] * __builtin_bit_cast(float, __builtin_amdgcn_readlane(i_w, k))
               + (sa * __builtin_bit_cast(float, __builtin_amdgcn_readlane(i_b, k)) + vv * __builtin_bit_cast(float, __builtin_amdgcn_readlane(i_kd, k)));
          S[k + 1] = S[k + 1] * __builtin_bit_cast(float, __builtin_amdgcn_readlane(i_w, k + 1))
               + (sa * __builtin_bit_cast(float, __builtin_amdgcn_readlane(i_b, k + 1)) + vv * __builtin_bit_cast(float, __builtin_amdgcn_readlane(i_kd, k + 1)));
          y0 += S[k] * __builtin_bit_cast(float, __builtin_amdgcn_readlane(i_r, k));
          y1 += S[k + 1] * __builtin_bit_cast(float, __builtin_amdgcn_readlane(i_r, k + 1));
        }
        yout[((size_t)d * NTOK + tok) * 512 + h * 64 + lane] = y0 + y1;
        fetch(j, s0 + j + 4);
      }
    }
    float* so = PQ + ((size_t)pq_entry(ch, c) * 2 + (ident ? 0 : 1)) * 4096 + lane * 64;
#pragma unroll
    for (int k = 0; k < 64; k += 4) *(float4*)(so + k) = make_float4(S[k], S[k + 1], S[k + 2], S[k + 3]);
  }
  if (p.nb > 384 && p.bid >= 384) ada_range(p, 192 + (p.bid - 384), p.nb - 384, 384);
}

__device__ __forceinline__ void ph_scanfix(const C& p) {
  const int tid = p.tid, lane = tid & 63, wave = tid >> 6;
  float* Sa = (float*)smem;
  float* Sb = Sa + 64 * 65;
  float* Pl = Sb + 64 * 65;
  float* YD = (float*)(p.ws + WS_YD);
  const float* UD = (const float*)(p.ws + WS_UD);
  const float* PQ = (const float*)(p.ws + WS_PQ);
  for (int it = p.bid; it < 480; it += p.nb) {
    int ch, c, nch;
    if (it < 224) { ch = it / 7; c = 1 + it % 7; nch = 8; } else { ch = 32 + (it - 224); c = 1; nch = 2; }
    int b, h, d, T, tok0;
    if (ch < 32) { b = ch >> 4; h = (ch >> 1) & 7; d = ch & 1; T = 1024; tok0 = NPR + b * 1024; }
    else { const int c2 = ch - 32; b = c2 >> 4; h = (c2 >> 1) & 7; d = c2 & 1; T = 256; tok0 = b * 256; }
    { const float* q0 = PQ + ((size_t)pq_entry(ch, 0) * 2 + 1) * 4096;
      for (int i = tid; i < 4096; i += 256) Sa[(i >> 6) * 65 + (i & 63)] = q0[i]; }
    float* cur = Sa; float* nxt = Sb;
    const bool emit = (ch >= 32) && (c == nch - 1);
    const int nmul = (c - 1) + (emit ? 1 : 0);
    const int v = tid >> 2, kq = (tid & 3) * 16;
    for (int m = 0; m < nmul; ++m) {
      const int cc = 1 + m;
      const float* Pg = PQ + ((size_t)pq_entry(ch, cc) * 2 + 0) * 4096;
      const float* Qg = Pg + 4096;
      __syncthreads();
      for (int i = tid; i < 1024; i += 256) *(float4*)(Pl + i * 4) = *(const float4*)(Pg + i * 4);
      __syncthreads();
      float acc[16];
#pragma unroll
      for (int j = 0; j < 16; j += 4) { const float4 q = *(const float4*)(Qg + v * 64 + kq + j); acc[j] = q.x; acc[j + 1] = q.y; acc[j + 2] = q.z; acc[j + 3] = q.w; }
      for (int i = 0; i < 64; ++i) {
        const float a = cur[v * 65 + i];
#pragma unroll
        for (int j = 0; j < 16; j += 4) {
          const float4 pv = *(const float4*)(Pl + i * 64 + kq + j);
          acc[j] += a * pv.x; acc[j + 1] += a * pv.y; acc[j + 2] += a * pv.z; acc[j + 3] += a * pv.w;
        }
      }
      if (emit && m == nmul - 1) {
        float* so = p.out + O_ST + ((size_t)((b * 2 + d) * 8 + h) * 64 + v) * 64 + kq;
#pragma unroll
        for (int j = 0; j < 16; j += 4) *(float4*)(so + j) = make_float4(acc[j], acc[j + 1], acc[j + 2], acc[j + 3]);
      } else {
#pragma unroll
        for (int j = 0; j < 16; ++j) nxt[v * 65 + kq + j] = acc[j];
        float* t = cur; cur = nxt; nxt = t;
      }
    }
    __syncthreads();
    float sr[64];
#pragma unroll
    for (int i = 0; i < 64; ++i) sr[i] = cur[lane * 65 + i];
    __syncthreads();
    float* Ul = Sb + wave * 2048;
    const int tinc = d ? -1 : 1;
    const int tokA = tok0 + (d ? T - 1 - c * CH_L : c * CH_L);
    {
      float uv[32];
#pragma unroll
      for (int s = 0; s < 32; ++s) uv[s] = UD[((size_t)d * NTOK + (tokA + (wave * 32 + s) * tinc)) * 512 + h * 64 + lane];
#pragma unroll
      for (int s = 0; s < 32; ++s) Ul[s * 64 + lane] = uv[s];
    }
    __syncthreads();
    float yv[32];
#pragma unroll
    for (int s = 0; s < 32; ++s) yv[s] = YD[((size_t)d * NTOK + (tokA + (wave * 32 + s) * tinc)) * 512 + h * 64 + lane];
#pragma unroll
    for (int s = 0; s < 32; ++s) {
      const int tok = tokA + (wave * 32 + s) * tinc;
      float a0 = 0.f, a1 = 0.f;
#pragma unroll
      for (int i = 0; i < 64; i += 4) {
        const float4 u = *(const float4*)(Ul + s * 64 + i);
        a0 += sr[i] * u.x; a1 += sr[i + 1] * u.y; a0 += sr[i + 2] * u.z; a1 += sr[i + 3] * u.w;
      }
      YD[((size_t)d * NTOK + tok) * 512 + h * 64 + lane] = yv[s] + (a0 + a1);
    }
    __syncthreads();
  }
}

__device__ __forceinline__ void ph_post(const C& p) {
  const int tid = p.tid, lane = tid & 63, wave = tid >> 6;
  const float* ZM = (const float*)(p.ws + WS_ZM);
  const float* YD = (const float*)(p.ws + WS_YD);
  const float* GG = (const float*)(p.ws + WS_GG);
  bf16_t* YC = (bf16_t*)(p.ws + WS_YCAT);
  const float* rk = p.in[21]; const float* lnw = p.in[22]; const float* lnb = p.in[23];
  for (int tok = p.bid * 4 + wave; tok < NTOK; tok += p.nb * 4) {
    const int c = lane * 8;
    float y[8], r[8], k[8], v[8], g[8];
#pragma unroll
    for (int q = 0; q < 2; ++q) {
      const float4 a = *(const float4*)(YD + (size_t)tok * 512 + c + q * 4), b = *(const float4*)(YD + ((size_t)NTOK + tok) * 512 + c + q * 4);
      y[q * 4] = a.x + b.x; y[q * 4 + 1] = a.y + b.y; y[q * 4 + 2] = a.z + b.z; y[q * 4 + 3] = a.w + b.w;
      const float4 rr = *(const float4*)(ZM + (size_t)tok * ZMC + c + q * 4), kk = *(const float4*)(ZM + (size_t)tok * ZMC + 512 + c + q * 4), vv = *(const float4*)(ZM + (size_t)tok * ZMC + 1024 + c + q * 4);
      r[q * 4] = rr.x; r[q * 4 + 1] = rr.y; r[q * 4 + 2] = rr.z; r[q * 4 + 3] = rr.w;
      k[q * 4] = kk.x; k[q * 4 + 1] = kk.y; k[q * 4 + 2] = kk.z; k[q * 4 + 3] = kk.w;
      v[q * 4] = vv.x; v[q * 4 + 1] = vv.y; v[q * 4 + 2] = vv.z; v[q * 4 + 3] = vv.w;
      const float4 gg = *(const float4*)(GG + (size_t)tok * 512 + c + q * 4);
      g[q * 4] = gg.x; g[q * 4 + 1] = gg.y; g[q * 4 + 2] = gg.z; g[q * 4 + 3] = gg.w;
    }
    float sm = 0.f, bn = 0.f;
#pragma unroll
    for (int i = 0; i < 8; ++i) { sm += y[i]; bn += r[i] * k[i] * rk[c + i]; }
    sm += swz<1>(sm); sm += swz<2>(sm); sm += swz<4>(sm);
    bn += swz<1>(bn); bn += swz<2>(bn); bn += swz<4>(bn);
    const float mean = sm * (1.f / 64.f);
    float vr = 0.f;
#pragma unroll
    for (int i = 0; i < 8; ++i) { const float dd = y[i] - mean; vr += dd * dd; }
    vr += swz<1>(vr); vr += swz<2>(vr); vr += swz<4>(vr);
    const float rs = rsqrtf(vr * (1.f / 64.f) + GN_EPS);
    float o[8];
#pragma unroll
    for (int i = 0; i < 8; ++i) o[i] = ((y[i] - mean) * rs * lnw[c + i] + lnb[c + i] + bn * v[i]) * g[i];
    uint4 w; w.x = pk2(o[0], o[1]); w.y = pk2(o[2], o[3]); w.z = pk2(o[4], o[5]); w.w = pk2(o[6], o[7]);
    *(uint4*)(YC + (size_t)tok * DM + 512 + c) = w;
  }
}

__device__ __forceinline__ void ph_gemm_out(const C& p, const float* W, int layer, bool from_inputs) {
  const bf16_t* A = (const bf16_t*)(p.ws + WS_YCAT);
  const float* mod = (const float*)(p.ws + WS_MOD);
  float* X = (float*)(p.ws + WS_XCUR);
  for (int t = p.vb; t < 48 * 8; t += p.nb) {
    int mt_, nt_; tile_mn(t, 48, 8, mt_, nt_);
    const int m0 = mt_ * 128, n0 = nt_ * 128;
    const float* gate = mod + (size_t)(layer * 3 + modrow(m0)) * 6144 + 2 * 1024;
    const float* xin = from_inputs ? (m0 < NPR ? p.in[0] + (size_t)m0 * DM : p.in[1] + (size_t)(m0 - NPR) * DM) : X + (size_t)m0 * DM;
    const float* xr_ = xin + (size_t)(p.tid >> 1) * DM + n0 + (p.tid & 1) * 64;
    const float t0_ = xr_[0], t1_ = xr_[32];
    gemm_tile<1>(p.tid, 1024,
      [=](int m, int k) { return *(const uint4*)(A + (size_t)(m0 + m) * DM + k); },
      [=](int, int k, int n) { return ldg4(W, (unsigned)(k * DM + n0 + n)); },
      [=](int m, int n, const float (&v)[1][4]) {
        const float gt = gate[n0 + n];
#pragma unroll
        for (int i = 0; i < 4; ++i) X[(size_t)(m0 + m + i) * DM + n0 + n] = xin[(size_t)(m + i) * DM + n0 + n] + gt * v[0][i];
      });
    asm volatile("" :: "v"(t0_), "v"(t1_));
  }
}

__device__ __forceinline__ void ph_topk(const C& p) {
  const int tid = p.tid;
  unsigned* keys = (unsigned*)smem;
  unsigned* hist = keys + 4096;
  unsigned* ctl = hist + 256;
  unsigned* gsum = ctl + 8;
  const float* aff = (const float*)(p.ws + WS_AFF);
  int* IDX = (int*)(p.ws + WS_IDX);
  int* SEL = (int*)(p.ws + WS_SEL);
  for (int it = p.bid; it < 32; it += p.nb) {
    const int grp = it >> 4, e = it & 15;
    const int n = grp ? NSA : NPR, cap = n >> 3;
    const float* a = aff + (size_t)(grp * 16 + e) * 4096;
    for (int i = tid; i < n; i += 256) keys[i] = __float_as_uint(a[i]);
    unsigned prefix = 0, mask = 0, need = cap;
    for (int pass = 0; pass < 4; ++pass) {
      const int shift = 24 - 8 * pass;
      hist[tid] = 0;
      __syncthreads();
      for (int i = tid; i < n; i += 256) { const unsigned k = keys[i]; if ((k & mask) == prefix) atomicAdd(&hist[(k >> shift) & 255u], 1u); }
      __syncthreads();
      if (tid < 16) {
        unsigned g = 0;
#pragma unroll
        for (int j = 0; j < 16; ++j) g += hist[tid * 16 + j];
        gsum[tid] = g;
      }
      __syncthreads();
      {
        const unsigned hb = hist[tid];
        const int g = tid >> 4, bl = tid & 15;
        unsigned cum = 0;
#pragma unroll
        for (int q = 1; q < 16; ++q) {
          const unsigned gv = gsum[(g + q) & 15], hv = hist[(tid & ~15) + ((bl + q) & 15)];
          cum += (g + q < 16) ? gv : 0u;
          cum += (bl + q < 16) ? hv : 0u;
        }
        if (cum < need && cum + hb >= need) { ctl[0] = tid; ctl[1] = need - cum; }
      }
      __syncthreads();
      prefix |= ctl[0] << shift; mask |= 255u << shift; need = ctl[1];
      __syncthreads();
    }
    if (tid == 0) { ctl[2] = 0; ctl[3] = 0; }
    __syncthreads();
    const unsigned T = prefix;
    for (int i = tid; i < n; i += 256) if (keys[i] == T) atomicAdd(&ctl[3], 1u);
    __syncthreads();
    const bool all_eq = ctl[3] == need;
    const int obase = e * 768 + (grp ? 512 : 0);
    for (int i = tid; i < n; i += 256) {
      const unsigned k = keys[i];
      bool sel = k > T;
      if (k == T) { if (all_eq) sel = true; else { unsigned rk = 0; for (int j = 0; j < i; ++j) rk += (keys[j] == T); sel = rk < need; } }
      if (sel) {
        const unsigned slot = atomicAdd(&ctl[2], 1u);
        IDX[obase + slot] = i + grp * NPR;
        SEL[(i + grp * NPR) * 16 + e] = (int)(obase - e * 768 + slot);
      }
    }
    __syncthreads();
  }
}

__device__ __forceinline__ void ph_moe_up(const C& p, int layer) {
  const bf16_t* H = (const bf16_t*)(p.ws + WS_H);
  const int* IDX = (const int*)(p.ws + WS_IDX);
  bf16_t* HID = (bf16_t*)(p.ws + WS_HID);
  for (int t = p.vb; t < 1536; t += p.nb) {
    const int e = t / 96, rem = t % 96, m0 = (rem % 6) * 128, n0 = (rem / 6) * 64;
    const float* W1 = p.in[32] + ((size_t)layer * 16 + e) * 1024 * 1024;
    const float* W3 = p.in[33] + ((size_t)layer * 16 + e) * 1024 * 1024;
    const int myrow = IDX[e * 768 + m0 + (p.tid >> 1)];
    const bf16_t* arow = H + (size_t)myrow * DM;
    gemm_core<1, true>(p.tid, 1024,
      [=](int, int k) { return *(const uint4*)(arow + k); },
      [=](int, int k, int n) { const int seg = n >> 5; return ldg4((seg & 1) ? W3 : W1, (unsigned)(k * 1024 + n0 + (seg >> 1) * 32 + (n & 31))); },
      [=](int m, int n, const float (&v)[2][4]) {
#pragma unroll
        for (int i = 0; i < 4; ++i) {
          const float a = v[0][i];
          HID[((size_t)e * 768 + m0 + m + i) * 1024 + n0 + n] = f2bf(a * fsigmoid_(a) * v[1][i]);
        }
      });
  }
}

__device__ __forceinline__ void ph_moe_down(const C& p, int layer) {
  const bf16_t* HID = (const bf16_t*)(p.ws + WS_HID);
  bf16_t* YE = (bf16_t*)(p.ws + WS_YE);
  for (int t = p.vb; t < 768; t += p.nb) {
    const int e = t / 48, rem = t % 48, m0 = (rem % 6) * 128, n0 = (rem / 6) * 128;
    const float* W2 = p.in[34] + ((size_t)layer * 16 + e) * 1024 * 1024;
    const bf16_t* A = HID + ((size_t)e * 768 + m0) * 1024;
    bf16_t* Y = YE + ((size_t)e * 768 + m0) * 1024 + n0;
    gemm_tile<1>(p.tid, 1024,
      [=](int m, int k) { return *(const uint4*)(A + (size_t)m * 1024 + k); },
      [=](int, int k, int n) { return ldg4(W2, (unsigned)(k * 1024 + n0 + n)); },
      [=](int m, int n, const float (&v)[1][4]) {
#pragma unroll
        for (int i = 0; i < 4; ++i) Y[(size_t)(m + i) * 1024 + n] = f2bf(v[0][i]);
      });
  }
}

__device__ __forceinline__ void ph_gemm_in1(const C& p) {
  const bf16_t* H = (const bf16_t*)(p.ws + WS_H);
  const float* W = p.in[25];
  float* Z1 = (float*)(p.ws + WS_Z1);
  for (int t = p.vb; t < 48 * 6; t += p.nb) {
    int mt_, nt_; tile_mn(t, 48, 6, mt_, nt_);
    const int m0 = mt_ * 128, n0 = nt_ * 128;
    gemm_tile<1>(p.tid, 1024,
      [=](int m, int k) { return *(const uint4*)(H + (size_t)(m0 + m) * DM + k); },
      [=](int, int k, int n) { return (n0 + n < IN1C) ? ldg4(W, (unsigned)(k * IN1C + n0 + n)) : make_float4(0.f, 0.f, 0.f, 0.f); },
      [=](int m, int n, const float (&v)[1][4]) {
        if (n0 + n < IN1C) {
#pragma unroll
          for (int i = 0; i < 4; ++i) Z1[(size_t)(m0 + m + i) * IN1C + n0 + n] = v[0][i];
        }
      });
  }
}

__device__ __forceinline__ int kofs(int seq) { return seq < 16 ? seq * 256 : 4096 + (seq - 16) * 1280; }
__device__ __forceinline__ void keyrow_geom(int row, int& seq, int& pos, int& nk) {
  if (row < NPR) { seq = row >> 8; pos = row & 255; nk = 256; }
  else if (row < NTOK) { seq = 16 + ((row - NPR) >> 10); pos = 256 + ((row - NPR) & 1023); nk = 1280; }
  else { seq = 16 + ((row - NTOK) >> 8); pos = (row - NTOK) & 255; nk = 1280; }
}

__device__ __forceinline__ int kfrag_off(int key, int d) { return (d >> 4) * 512 + ((d >> 3) & 1) * 256 + key * 8 + (d & 7); }

__device__ __forceinline__ void ph_mla_norm(const C& p) {
  const int tid = p.tid, lane = tid & 63, wave = tid >> 6;
  const float* Z1 = (const float*)(p.ws + WS_Z1);
  const float* tab = (const float*)(p.ws + WS_ROPE);
  bf16_t* CQN = (bf16_t*)(p.ws + WS_CQN);
  bf16_t* CKVN = (bf16_t*)(p.ws + WS_CKVN);
  bf16_t* KH = (bf16_t*)(p.ws + WS_KH);
  const float* qn = p.in[26]; const float* kvn = p.in[27];
  for (int row = p.bid * 4 + wave; row < NKROW; row += p.nb * 4) {
    if (row < NTOK) {
      const float* z = Z1 + (size_t)row * IN1C;
      float cq[6], ss = 0.f;
#pragma unroll
      for (int i = 0; i < 6; ++i) { cq[i] = z[i * 64 + lane]; ss += cq[i] * cq[i]; }
      ss = wave_sum(ss, lane);
      const float rq = rsqrtf(ss * (1.f / 384.f) + RMS_EPS);
#pragma unroll
      for (int i = 0; i < 6; ++i) CQN[(size_t)row * 384 + i * 64 + lane] = f2bf(cq[i] * rq * qn[i * 64 + lane]);
      float ck[4], s2 = 0.f;
#pragma unroll
      for (int i = 0; i < 4; ++i) { ck[i] = z[384 + i * 64 + lane]; s2 += ck[i] * ck[i]; }
      s2 = wave_sum(s2, lane);
      const float rk = rsqrtf(s2 * (1.f / 256.f) + RMS_EPS);
#pragma unroll
      for (int i = 0; i < 4; ++i) {
        const float o = ck[i] * rk * kvn[i * 64 + lane];
        CKVN[(size_t)row * 256 + i * 64 + lane] = f2bf(o);
        if (row < NPR) p.out[O_CKV + (size_t)row * 256 + i * 64 + lane] = o;
      }
      float kp = z[640 + lane];
      if (row < NPR) {
        p.out[O_KPE + (size_t)row * 64 + lane] = kp;
      } else {
        const int tt = (row - NPR) & 1023;
        const int grp = lane >> 5, idx = lane & 31, f = idx & 15;
        const int pos = grp ? (tt & 63) : (tt >> 6);
        const float cs = tab[(pos * 16 + f) * 2], sn = tab[(pos * 16 + f) * 2 + 1];
        const float pr = swz<16>(kp);
        kp = (idx < 16) ? (kp * cs - pr * sn) : (pr * sn + kp * cs);
      }
      { int seq, pos, nk; keyrow_geom(row, seq, pos, nk);
        const bf16_t kb = f2bf(kp);
#pragma unroll
        for (int hh = 0; hh < 8; ++hh) KH[((size_t)kofs(seq) * 8 + (size_t)hh * nk + (pos & ~31)) * 192 + kfrag_off(pos & 31, 128 + lane)] = kb; }
    } else {
      const int cr = row - NTOK;
      const float* c = p.in[3] + (size_t)cr * 256;
#pragma unroll
      for (int i = 0; i < 4; ++i) CKVN[(size_t)row * 256 + i * 64 + lane] = f2bf(c[i * 64 + lane]);
      { int seq, pos, nk; keyrow_geom(row, seq, pos, nk);
        const bf16_t kb = f2bf(p.in[4][(size_t)cr * 64 + lane]);
#pragma unroll
        for (int hh = 0; hh < 8; ++hh) KH[((size_t)kofs(seq) * 8 + (size_t)hh * nk + (pos & ~31)) * 192 + kfrag_off(pos & 31, 128 + lane)] = kb; }
    }
  }
}

__device__ __forceinline__ void ph_mla_qkv(const C& p) {
  const bf16_t* CQN = (const bf16_t*)(p.ws + WS_CQN);
  const bf16_t* CKVN = (const bf16_t*)(p.ws + WS_CKVN);
  const float* tab = (const float*)(p.ws + WS_ROPE);
  bf16_t* QB = (bf16_t*)(p.ws + WS_QBUF);
  bf16_t* KH = (bf16_t*)(p.ws + WS_KH);
  bf16_t* VT = (bf16_t*)(p.ws + WS_VT);
  const float* Wq = p.in[28]; const float* Wkv = p.in[29];
  for (int t = p.vb; t < 576 + 832; t += p.nb) {
    if (t < 576) {
      int mt_, nt_; tile_mn(t, 48, 12, mt_, nt_);
      const int m0 = mt_ * 128, n0 = nt_ * 128;
      gemm_tile<1>(p.tid, 384,
        [=](int m, int k) { return *(const uint4*)(CQN + (size_t)(m0 + m) * 384 + k); },
        [=](int, int k, int n) { return ldg4(Wq, (unsigned)(k * 1536 + n0 + n)); },
        [=](int m, int n, const float (&v)[1][4]) {
          const int nn = n0 + n;
          const int sub = (nn % 192) >> 5;
          float o[4] = {v[0][0], v[0][1], v[0][2], v[0][3]};
          if (m0 >= NPR && sub >= 4) {
            const int idx = nn & 31, f = idx & 15;
#pragma unroll
            for (int i = 0; i < 4; ++i) {
              const int tt = (m0 + m + i - NPR) & 1023;
              const int pos = (sub == 5) ? (tt & 63) : (tt >> 6);
              const float cs = tab[(pos * 16 + f) * 2], sn = tab[(pos * 16 + f) * 2 + 1];
              const float pr = swz<16>(o[i]);
              o[i] = (idx < 16) ? (o[i] * cs - pr * sn) : (pr * sn + o[i] * cs);
            }
          }
#pragma unroll
          for (int i = 0; i < 4; ++i) QB[(size_t)(m0 + m + i) * 1536 + nn] = f2bf(o[i]);
        });
    } else {
      const int t2 = t - 576;
      int mt_, nt_; tile_mn(t2, 52, 16, mt_, nt_);
      const int m0 = mt_ * 128, n0 = nt_ * 128;
      int seq, pos0, nk; keyrow_geom(m0, seq, pos0, nk);
      const int h = n0 >> 8;
      const bool isv = (n0 & 128) != 0;
      bf16_t* kdst0 = KH + ((size_t)kofs(seq) * 8 + (size_t)h * nk) * 192;
      bf16_t* vdst = VT + ((size_t)kofs(seq) * 8 + (size_t)h * nk) * 128;
      auto alkv = [=](int m, int k) { return *(const uint4*)(CKVN + (size_t)(m0 + m) * 256 + k); };
      auto blkv = [=](int, int k, int n) { return ldg4(Wkv, (unsigned)(k * 2048 + n0 + n)); };
      if (!isv) {
        gemm_tile<1>(p.tid, 256, alkv, blkv,
          [=](int m, int n, const float (&v)[1][4]) {
#pragma unroll
            for (int i = 0; i < 4; ++i) { const int pp = pos0 + m + i; kdst0[(size_t)(pp & ~31) * 192 + kfrag_off(pp & 31, n)] = f2bf(v[0][i]); }
          });
      } else {
        gemm_tile<1>(p.tid, 256, alkv, blkv,
          [=](int m, int n, const float (&v)[1][4]) {
            const int pos = pos0 + m;
            uint2 w; w.x = pk2(v[0][0], v[0][1]); w.y = pk2(v[0][2], v[0][3]);
            const int kk = pos & 31;
            *(uint2*)(vdst + (size_t)(pos >> 5) * 4096 + (((n >> 5) * 2 + (kk >> 4)) * 2 + ((kk >> 2) & 1)) * 256 + (n & 31) * 8 + ((kk >> 3) & 1) * 4) = w;
          });
      }
    }
  }
}

__device__ __forceinline__ void attn_item(const C& p, int seq, int hd, int qtok0, int tid) {
  const int lane = tid & 63, wave = tid >> 6, l31 = lane & 31, lh = lane >> 5;
  const bf16_t* QB = (const bf16_t*)(p.ws + WS_QBUF);
  const bf16_t* KH = (const bf16_t*)(p.ws + WS_KH);
  const bf16_t* VT = (const bf16_t*)(p.ws + WS_VT);
  bf16_t* OUT = (bf16_t*)(p.ws + WS_YCAT);
  float* Oacc = (float*)smem;
  float* sm_m = Oacc + 8192;
  float* sm_l = sm_m + 128;
  const int qt = wave & 1, khf = wave >> 1;
  const int nk = seq < 16 ? 256 : 1280;
  const int ntile = nk >> 5, tpw = ntile >> 1;
  const bf16_t* vt = VT + ((size_t)kofs(seq) * 8 + (size_t)hd * nk) * 128;
  const bf16_t* kh = KH + ((size_t)kofs(seq) * 8 + (size_t)hd * nk) * 192;
  bf16_t* Qs = (bf16_t*)(sm_l + 128);
#pragma unroll
  for (int i = 0; i < 6; ++i) {
    const int idx = tid + i * 256, row = idx / 24, c8 = (idx % 24) * 8;
    *(uint4*)&Qs[row * 200 + c8] = *(const uint4*)(QB + (size_t)(qtok0 + row) * 1536 + hd * 192 + c8);
  }
  __syncthreads();
  const bf16_t* qs = Qs + (qt * 32 + l31) * 200 + lh * 8;
  f32x16 oacc[4];
#pragma unroll
  for (int dt = 0; dt < 4; ++dt)
#pragma unroll
    for (int r = 0; r < 16; ++r) oacc[dt][r] = 0.f;
  float mrun = -1e30f, lrun = 0.f;
#pragma unroll 1
  for (int kt = khf * tpw; kt < (khf + 1) * tpw; ++kt) {
    bf16x8 kf[12]; uint4 vf[8];
    const bf16_t* kn = kh + (size_t)kt * 6144 + lh * 256 + l31 * 8;
#pragma unroll
    for (int ks = 0; ks < 12; ++ks) kf[ks] = *(const bf16x8*)(kn + ks * 512);
    const bf16_t* vp = vt + (size_t)kt * 4096 + lh * 256 + l31 * 8;
#pragma unroll
    for (int dt = 0; dt < 4; ++dt) {
      vf[dt * 2] = *(const uint4*)(vp + (dt * 2 + 0) * 512); vf[dt * 2 + 1] = *(const uint4*)(vp + (dt * 2 + 1) * 512);
    }
    __builtin_amdgcn_sched_barrier(0);
    f32x16 s;
#pragma unroll
    for (int r = 0; r < 16; ++r) s[r] = 0.f;
#pragma unroll
    for (int ks = 0; ks < 12; ++ks) s = __builtin_amdgcn_mfma_f32_32x32x16_bf16(kf[ks], *(const bf16x8*)(qs + ks * 16), s, 0, 0, 0);
    float tmax = -1e30f;
#pragma unroll
    for (int r = 0; r < 16; ++r) { s[r] *= ATTN_SCALE; tmax = fmaxf(tmax, s[r]); }
    tmax = fmaxf(tmax, shx32(tmax, lane));
    const float mnew = fmaxf(mrun, tmax);
    const float alpha = expf(mrun - mnew);
    float ps = 0.f;
#pragma unroll
    for (int r = 0; r < 16; ++r) { s[r] = expf(s[r] - mnew); ps += s[r]; }
    ps += shx32(ps, lane);
    lrun = lrun * alpha + ps; mrun = mnew;
#pragma unroll
    for (int dt = 0; dt < 4; ++dt)
#pragma unroll
      for (int r = 0; r < 16; ++r) oacc[dt][r] *= alpha;
#pragma unroll
    for (int sh = 0; sh < 2; ++sh) {
      uint4 pw;
      pw.x = pk2(s[sh * 8 + 0], s[sh * 8 + 1]); pw.y = pk2(s[sh * 8 + 2], s[sh * 8 + 3]);
      pw.z = pk2(s[sh * 8 + 4], s[sh * 8 + 5]); pw.w = pk2(s[sh * 8 + 6], s[sh * 8 + 7]);
      const bf16x8 pf = __builtin_bit_cast(bf16x8, pw);
#pragma unroll
      for (int dt = 0; dt < 4; ++dt)
        oacc[dt] = __builtin_amdgcn_mfma_f32_32x32x16_bf16(__builtin_bit_cast(bf16x8, vf[dt * 2 + sh]), pf, oacc[dt], 0, 0, 0);
    }
  }
  for (int i = tid; i < 8192; i += 256) Oacc[i] = 0.f;
  if (lh == 0) { sm_m[wave * 32 + l31] = mrun; sm_l[wave * 32 + l31] = lrun; }
  __syncthreads();
  {
    const float m0 = sm_m[qt * 32 + l31], m1 = sm_m[(qt + 2) * 32 + l31];
    const float M = fmaxf(m0, m1);
    const float L = sm_l[qt * 32 + l31] * expf(m0 - M) + sm_l[(qt + 2) * 32 + l31] * expf(m1 - M);
    const float f = expf(mrun - M) / L;
    float* oq = Oacc + qt * 4096;
#pragma unroll
    for (int dt = 0; dt < 4; ++dt)
#pragma unroll
      for (int r = 0; r < 16; ++r) {
        const int d = dt * 32 + (r & 3) + 8 * (r >> 2) + 4 * lh;
        atomicAdd(&oq[d * 32 + l31], oacc[dt][r] * f);
      }
  }
  __syncthreads();
  {
    const int q = tid >> 2, dc = (tid & 3) * 32;
    const float* oq = Oacc + (q >> 5) * 4096 + (q & 31);
    bf16_t* dst = OUT + (size_t)(qtok0 + q) * DM + hd * 128 + dc;
#pragma unroll
    for (int h4 = 0; h4 < 4; ++h4) {
      float o[8];
#pragma unroll
      for (int i = 0; i < 8; ++i) o[i] = oq[(dc + h4 * 8 + i) * 32];
      uint4 w; w.x = pk2(o[0], o[1]); w.y = pk2(o[2], o[3]); w.z = pk2(o[4], o[5]); w.w = pk2(o[6], o[7]);
      *(uint4*)(dst + h4 * 8) = w;
    }
  }
  __syncthreads();
}
__device__ __forceinline__ void ph_attn(const C& p) {
  const int tid = p.tid;
  const int half = p.nb >> 1;
  if ((p.vb & 1) == 0) {
    for (int s_ = p.vb >> 1; s_ < 256; s_ += half) {
      const int b = s_ >> 7, hd = (s_ >> 4) & 7;
      attn_item(p, 16 + b, hd, NPR + b * 1024 + (s_ & 15) * 64, tid);
    }
  } else {
    for (int j = p.vb >> 1; j < 256; j += half) {
      for (int u = 0; u < 2; ++u) {
        const int i2 = j * 2 + u;
        const int b = i2 >> 5, hd = (i2 >> 2) & 7;
        attn_item(p, b, hd, b * 256 + (i2 & 3) * 64, tid);
      }
    }
  }
}

__device__ __forceinline__ void ph_final(const C& p) {
  const int tid = p.tid, lane = tid & 63, wave = tid >> 6;
  const float* X = (const float*)(p.ws + WS_XCUR);
  const float* g = p.in[35];
  for (int tok = p.bid * 4 + wave; tok < NTOK; tok += p.nb * 4) {
    const float* x = X + (size_t)tok * DM;
    float4 xv[4]; float ss = 0.f;
#pragma unroll
    for (int i = 0; i < 4; ++i) xv[i] = *(const float4*)(x + (i * 64 + lane) * 4);
    moe_combine_row(p, tok, 1, lane, xv);
#pragma unroll
    for (int i = 0; i < 4; ++i) ss += xv[i].x * xv[i].x + xv[i].y * xv[i].y + xv[i].z * xv[i].z + xv[i].w * xv[i].w;
    ss = wave_sum(ss, lane);
    const float rinv = rsqrtf(ss * (1.f / 1024.f) + RMS_EPS);
#pragma unroll
    for (int i = 0; i < 4; ++i) {
      const int d = (i * 64 + lane) * 4;
      const float4 gv = *(const float4*)(g + d);
      *(float4*)(p.out + O_Y + (size_t)tok * DM + d) = make_float4(xv[i].x * rinv * gv.x, xv[i].y * rinv * gv.y, xv[i].z * rinv * gv.z, xv[i].w * rinv * gv.w);
    }
  }
}

#define NPHASE 24
__device__ __forceinline__ void run_phase(const C& p, int ph) {
  switch (ph) {
    case 0: ph_ada(p); break;
    case 1: case 13: { const int L = ph == 13; ph_prep<false>(p, !L, p.in[9] + L * 1024, L, 0, nullptr); } break;
    case 2: ph_gemm_in0(p); break;
    case 3: ph_mix(p); break;
    case 4: ph_lora(p); break;
    case 5: ph_scan(p); break;
    case 6: ph_scanfix(p); break;
    case 7: ph_post(p); break;
    case 8: case 18: { const int L = ph == 18; ph_gemm_out(p, L ? p.in[30] : p.in[24], L, !L); } break;
    case 9: case 19: { const int L = ph == 19; ph_router(p, p.in[10] + L * 1024, L, p.in[31] + L * 1024 * 16); } break;
    case 10: case 20: ph_topk(p); break;
    case 11: case 21: ph_moe_up(p, ph == 21); break;
    case 12: case 22: ph_moe_down(p, ph == 22); break;
    case 14: ph_gemm_in1(p); break;
    case 15: ph_mla_norm(p); break;
    case 16: ph_mla_qkv(p); break;
    case 17: ph_attn(p); break;
    case 23: ph_final(p); break;
    default: break;
  }
}

__global__ void __launch_bounds__(256, 2) fwd_kernel(P p) {
  if (threadIdx.x == 0) xb_words = make_uint4(0u, 0u, 0u, 0u);
  __syncthreads();
  XcdBarrier bar = xcd_barrier_post((unsigned*)(p.ws + WS_BAR), (volatile LAS unsigned*)&xb_words);
  C c; (P&)c = p; c.nb = gridDim.x;
  const int wv_ = __builtin_amdgcn_readfirstlane(threadIdx.x >> 6);
#ifdef ONLY_PHASE
  c.tid = wv_ * 64 + (int)__builtin_amdgcn_mbcnt_hi(~0u, __builtin_amdgcn_mbcnt_lo(~0u, 0u)); c.bid = blockIdx.x; c.vb = (c.bid & 7) * (c.nb >> 3) + (c.bid >> 3);
  run_phase(c, ONLY_PHASE); xcd_barrier(bar);
#else
  for (int ph = p.ph_lo; ph < p.ph_hi; ++ph) {
    const int reps = (ph == p.probe_ph) ? p.probe_reps : 1;
    for (int r = 0; r < reps; ++r) {
      if (r) __syncthreads();
      int l_; asm volatile("v_mbcnt_lo_u32_b32 %0, -1, 0\n\tv_mbcnt_hi_u32_b32 %0, -1, %0" : "=v"(l_));
      int t_ = wv_ * 64 + l_, b_ = blockIdx.x; unsigned char* w_ = p.ws;
      asm volatile("" : "+v"(t_)); asm volatile("" : "+s"(b_)); asm volatile("" : "+s"(w_));
      c.tid = t_; c.bid = b_; c.ws = w_; c.vb = (b_ & 7) * (c.nb >> 3) + (b_ >> 3);
      run_phase(c, ph);
    }
    if (ph + 1 < p.ph_hi) xcd_barrier(bar);
  }
#endif
}

extern "C" void kernel_launch(void* const* d_in, const int* in_sizes, int n_in, void* d_out, int out_size, void* d_ws, size_t ws_size, hipStream_t stream) {
  static int grid = 0;
  if (grid == 0) {
    int dev = 0, cus = 0, per_cu = 0;
    hipGetDevice(&dev);
    hipDeviceGetAttribute(&cus, hipDeviceAttributeMultiprocessorCount, dev);
    hipOccupancyMaxActiveBlocksPerMultiprocessor(&per_cu, (const void*)fwd_kernel, 256, 0);
    (void)hipGetLastError();
    if (per_cu < 1) per_cu = 1;
    if (per_cu > 2) per_cu = 2;
    grid = cus * per_cu;
    grid &= ~7;
    if (grid < 8) grid = 8;
    if (ws_size < WS_END0) fprintf(stderr, "kernel_launch: workspace too small (%zu < %llu)\n", ws_size, (unsigned long long)WS_END0);
  }
  hipMemsetAsync((char*)d_ws + WS_BAR, 0, XCD_BAR_WORDS * 4, stream);
  P p{};
  for (int i = 0; i < 36; ++i) p.in[i] = (const float*)d_in[i];
  p.out = (float*)d_out; p.ws = (unsigned char*)d_ws;
  p.probe_ph = -1; p.probe_reps = 1;
#ifdef MULTI_LAUNCH
  for (int ph = 0; ph < NPHASE; ++ph) {
    p.ph_lo = ph; p.ph_hi = ph + 1;
    hipLaunchKernelGGL(fwd_kernel, dim3(grid), dim3(256), 0, stream, p);
  }
#else
  p.ph_lo = 0; p.ph_hi = NPHASE;
  hipLaunchKernelGGL(fwd_kernel, dim3(grid), dim3(256), 0, stream, p);
#endif
}
```

```cpp
#include <hip/hip_runtime.h>
#include <stdint.h>
#include <stdio.h>

typedef __attribute__((ext_vector_type(8))) short bf16x8;
typedef __attribute__((ext_vector_type(16))) float f32x16;
typedef unsigned short bf16_t;
typedef const __attribute__((address_space(4))) float cflt;
#define LAS __attribute__((address_space(3)))

#define NTOK 6144
#define NPR 4096
#define NSA 2048
#define DM 1024
#define IN0C 3456
#define ZMC 1920
#define IN1C 704
#define NKROW 6656
#define DECAY_SCALE 0.606531f
#define GN_EPS 64e-5f
#define RMS_EPS 1e-6f
#define ATTN_SCALE 0.07216878364870322f

#define WS_BAR   0ull
#define WS_MOD   (64ull << 10)
#define WS_ROPE  (WS_MOD + (256ull << 10))
#define WS_AFF   (WS_ROPE + (64ull << 10))
#define WS_IDX   (WS_AFF + (512ull << 10))
#define WS_GATE  (WS_IDX + (64ull << 10))
#define WS_H     (1ull << 20)
#define WS_YCAT  (WS_H + 12582912ull)
#define WS_XCUR  (WS_YCAT + 12582912ull)
#define WS_HID   (WS_XCUR + 25165824ull)
#define WS_Z     (WS_HID + 25165824ull)
#define WS_ZM    (WS_Z + 84934656ull)
#define WS_OPSA  (WS_ZM + 47185920ull)
#define WS_OPSB  (WS_OPSA + 25165824ull)
#define WS_GG    (WS_OPSB + 75497472ull)
#define WS_YD    (WS_GG + 12582912ull)
#define WS_UD    (WS_YD + 25165824ull)
#define WS_PQ    (WS_UD + 25165824ull)
#define WS_SEL   (WS_PQ + 25165824ull)
#define WS_END0  (WS_SEL + 393216ull)
#define WS_YE    WS_ZM
#define WS_Z1    WS_Z
#define WS_CQN   (WS_Z1 + 17301504ull)
#define WS_CKVN  (WS_CQN + 4718592ull)
#define WS_KPE   (WS_CKVN + 3407872ull)
#define WS_QBUF  (WS_KPE + 851968ull)
#define WS_KH    (WS_QBUF + 18874368ull)
#define WS_VT    (WS_KH + 20447232ull)

#define O_Y    0
#define O_ST   6291456
#define O_CKV  7340032
#define O_KPE  8388608

struct P {
  const float* in[36];
  float* out;
  unsigned char* ws;
  int ph_lo, ph_hi;
  int probe_ph, probe_reps;
};

struct C : P { int tid, bid, nb, vb; };

#define SMEM_BYTES 61440
__shared__ __attribute__((aligned(16))) unsigned char smem[SMEM_BYTES];
__shared__ uint4 xb_words;

__device__ __forceinline__ unsigned pk2(float lo, float hi) {
  typedef __attribute__((ext_vector_type(2))) __bf16 bf2;
  typedef __attribute__((ext_vector_type(2))) float fl2;
  fl2 f = {lo, hi};
  bf2 b = __builtin_convertvector(f, bf2);
  return __builtin_bit_cast(unsigned, b);
}
__device__ __forceinline__ bf16_t f2bf(float f) { return (bf16_t)(pk2(f, 0.f) & 0xffffu); }
__device__ __forceinline__ float bf2f(bf16_t b) { return __uint_as_float(((unsigned)b) << 16); }
__device__ __forceinline__ float sigmoidf_(float x) { return 1.f / (1.f + expf(-x)); }
__device__ __forceinline__ float fsigmoid_(float x) { return __builtin_amdgcn_rcpf(1.f + __builtin_amdgcn_exp2f(-1.4426950408889634f * x)); }
__device__ __forceinline__ float ftanh_(float x) { return 1.f - 2.f * __builtin_amdgcn_rcpf(1.f + __builtin_amdgcn_exp2f(2.8853900817779268f * x)); }
template <int M> __device__ __forceinline__ float swz(float v) {
  return __builtin_bit_cast(float, __builtin_amdgcn_ds_swizzle(__builtin_bit_cast(int, v), (M << 10) | 0x1f));
}
__device__ __forceinline__ float shx32(float v, int lane) {
  return __builtin_bit_cast(float, __builtin_amdgcn_ds_bpermute((lane ^ 32) << 2, __builtin_bit_cast(int, v)));
}
__device__ __forceinline__ float wave_sum(float v, int lane) {
  v += swz<1>(v); v += swz<2>(v); v += swz<4>(v); v += swz<8>(v); v += swz<16>(v); v += shx32(v, lane);
  return v;
}
__device__ __forceinline__ float4 ldg4(const float* base, unsigned off) { return *(const float4*)((const char*)base + (size_t)(off * 4u)); }
__device__ __forceinline__ int modrow(int tok) { return tok < NPR ? 0 : 1 + ((tok - NPR) >> 10); }

#define XB_TMO      128
#define XB_XCNT(j)  (256  + 64 * (j))
#define XB_XSUB(j)  (1280 + 64 * (j))
#define XB_XGEN(j)  (2304 + 64 * (j))
#define XB_TOP      3328
#define XB_TOPGEN   3392
#define XCD_BAR_WORDS 3456
#define XB_SPIN_CAP (1u << 20)
__device__ __forceinline__ unsigned xb_ld(unsigned* p)              { return __hip_atomic_load(p, __ATOMIC_RELAXED, __HIP_MEMORY_SCOPE_AGENT); }
__device__ __forceinline__ unsigned xb_add(unsigned* p, unsigned v) { return __hip_atomic_fetch_add(p, v, __ATOMIC_RELAXED, __HIP_MEMORY_SCOPE_AGENT); }
__device__ __forceinline__ unsigned xb_xcc_id() { return (unsigned)__builtin_amdgcn_s_getreg((3 << 11) | 20) & 0xFu; }
#define XB_SPIN(cond, bar) do { unsigned _sp = 0; while (cond) { __builtin_amdgcn_s_sleep(1); \
    if ((++_sp & 255u) == 0u) { if (xb_ld(&(bar)[XB_TMO])) break; if (_sp > XB_SPIN_CAP) { atomicAdd(&(bar)[XB_TMO], 1u); break; } } } } while (0)
struct XcdBarrier { unsigned* bar; unsigned x; volatile LAS unsigned* st; };
__device__ __forceinline__ XcdBarrier xcd_barrier_post(unsigned* bar, volatile LAS unsigned* st) {
  XcdBarrier b; b.bar = bar; b.x = xb_xcc_id(); b.st = st;
  if (threadIdx.x == 0) (void)xb_add(&bar[XB_XCNT(b.x)], 1u);
  return b;
}
__device__ __forceinline__ void xcd_barrier_complete(unsigned* bar, unsigned x, unsigned& nloc, unsigned& nx) {
  const unsigned G = gridDim.x * gridDim.y * gridDim.z;
  unsigned sum, cnt, mine, sp = 0u;
  for (;;) {
    sum = 0u; cnt = 0u; mine = 0u;
#pragma unroll
    for (unsigned j = 0; j < 16; ++j) { const unsigned c = xb_ld(&bar[XB_XCNT(j)]); sum += c; cnt += (c > 0u) ? 1u : 0u; mine = (j == x) ? c : mine; }
    if (sum == G) break;
    __builtin_amdgcn_s_sleep(1);
    if ((++sp & 255u) == 0u) { if (xb_ld(&bar[XB_TMO])) break; if (sp > XB_SPIN_CAP) { atomicAdd(&bar[XB_TMO], 1u); break; } }
  }
  nloc = mine > 0u ? mine : 1u; nx = cnt > 0u ? cnt : 1u;
}
__device__ __forceinline__ void xcd_barrier(const XcdBarrier& b) {
  asm volatile("s_waitcnt vmcnt(0)" ::: "memory");
  __syncthreads();
  if (threadIdx.x == 0) {
    unsigned* bar = b.bar;
    __builtin_amdgcn_s_waitcnt(0);
    unsigned nloc = b.st[0], nx = b.st[1];
    if (nloc == 0u) { xcd_barrier_complete(bar, b.x, nloc, nx); b.st[0] = nloc; b.st[1] = nx; }
    const unsigned old = xb_add(&bar[XB_XSUB(b.x)], 1u);
    const unsigned gen = old / nloc;
    if (old + 1u == (gen + 1u) * nloc) {
      __builtin_amdgcn_fence(__ATOMIC_RELEASE, "agent");
      asm volatile("s_waitcnt vmcnt(0)" ::: "memory");
      const unsigned og = xb_add(&bar[XB_TOP], 1u);
      const unsigned tg = og / nx;
      if (og + 1u == (tg + 1u) * nx) xb_add(&bar[XB_TOPGEN], 1u);
      else XB_SPIN(xb_ld(&bar[XB_TOPGEN]) == tg, bar);
      __builtin_amdgcn_fence(__ATOMIC_ACQUIRE, "agent");
      xb_add(&bar[XB_XGEN(b.x)], 1u);
      asm volatile("s_waitcnt vmcnt(0)" ::: "memory");
    } else {
      XB_SPIN(xb_ld(&bar[XB_XGEN(b.x)]) == gen, bar);
      __builtin_amdgcn_fence(__ATOMIC_ACQUIRE, "agent");
      asm volatile("s_waitcnt vmcnt(0)" ::: "memory");
    }
  }
  __syncthreads();
}

#define LDS_S 72
template <int NB, bool PAIR, class AL, class BL, class EP>
__device__ __forceinline__ void gemm_core(int tid_, int K, AL al, BL bl, EP ep) {
  bf16_t* As = (bf16_t*)smem;
  bf16_t* Bs = As + 128 * LDS_S;
  const int tid = tid_, lane = tid & 63, wave = tid >> 6;
  const int wm = wave >> 1, wn = wave & 1, l31 = lane & 31, lh = lane >> 5;
  f32x16 acc[NB][2][2];
#pragma unroll
  for (int b = 0; b < NB; ++b)
#pragma unroll
    for (int i = 0; i < 2; ++i)
#pragma unroll
      for (int j = 0; j < 2; ++j)
#pragma unroll
        for (int r = 0; r < 16; ++r) acc[b][i][j][r] = 0.f;
  const int arow = tid >> 1, akb = (tid & 1) * 32;
  const int bng = (tid & 31) * 4, bkg = (tid >> 5) * 8;
  uint4 ra[4]; float4 rb[2][8];
#pragma unroll
  for (int i = 0; i < 4; ++i) ra[i] = al(arow, akb + i * 8);
#pragma unroll
  for (int i = 0; i < 8; ++i) rb[0][i] = bl(0, bkg + i, bng);
  if (K > 64) {
#pragma unroll
    for (int i = 0; i < 8; ++i) rb[1][i] = bl(0, 64 + bkg + i, bng);
  }
#pragma unroll 1
  for (int kbase = 0; kbase < K; kbase += 128) {
#pragma unroll
  for (int hb = 0; hb < 2; ++hb) {
    const int k0 = kbase + hb * 64;
    if (k0 < K) {
#pragma unroll
    for (int i = 0; i < 4; ++i) *(uint4*)&As[arow * LDS_S + akb + i * 8] = ra[i];
#pragma unroll
    for (int j = 0; j < 4; ++j) {
      uint4 w;
      w.x = pk2(((const float*)&rb[hb][0])[j], ((const float*)&rb[hb][1])[j]);
      w.y = pk2(((const float*)&rb[hb][2])[j], ((const float*)&rb[hb][3])[j]);
      w.z = pk2(((const float*)&rb[hb][4])[j], ((const float*)&rb[hb][5])[j]);
      w.w = pk2(((const float*)&rb[hb][6])[j], ((const float*)&rb[hb][7])[j]);
      *(uint4*)&Bs[(bng + j) * LDS_S + bkg] = w;
    }
    __syncthreads();
    if (k0 + 64 < K) {
#pragma unroll
      for (int i = 0; i < 4; ++i) ra[i] = al(arow, k0 + 64 + akb + i * 8);
    }
    if (k0 + 128 < K) {
#pragma unroll
      for (int i = 0; i < 8; ++i) rb[hb][i] = bl(0, k0 + 128 + bkg + i, bng);
    }
#pragma unroll
    for (int ks = 0; ks < 4; ++ks) {
      bf16x8 af[2], bfr[2];
#pragma unroll
      for (int mt = 0; mt < 2; ++mt) af[mt] = *(const bf16x8*)&As[(wm * 64 + mt * 32 + l31) * LDS_S + ks * 16 + lh * 8];
#pragma unroll
      for (int nt = 0; nt < 2; ++nt) bfr[nt] = *(const bf16x8*)&Bs[(wn * 64 + nt * 32 + l31) * LDS_S + ks * 16 + lh * 8];
#pragma unroll
      for (int mt = 0; mt < 2; ++mt)
#pragma unroll
        for (int nt = 0; nt < 2; ++nt) acc[0][mt][nt] = __builtin_amdgcn_mfma_f32_32x32x16_bf16(af[mt], bfr[nt], acc[0][mt][nt], 0, 0, 0);
    }
    __syncthreads();
    }
  }
  }
  int eM = wm * 64 + lh * 4, eN = l31;
  asm volatile("" : "+v"(eM), "+v"(eN));
  if constexpr (PAIR) {
#pragma unroll
    for (int mt = 0; mt < 2; ++mt)
#pragma unroll
      for (int rg = 0; rg < 4; ++rg) {
        float v[2][4];
#pragma unroll
        for (int i = 0; i < 4; ++i) { v[0][i] = acc[0][mt][0][rg * 4 + i]; v[1][i] = acc[0][mt][1][rg * 4 + i]; }
        ep(eM + mt * 32 + rg * 8, wn * 32 + eN, v);
      }
  } else {
#pragma unroll
    for (int mt = 0; mt < 2; ++mt)
#pragma unroll
      for (int nt = 0; nt < 2; ++nt)
#pragma unroll
        for (int rg = 0; rg < 4; ++rg) {
          float v[NB][4];
#pragma unroll
          for (int b = 0; b < NB; ++b)
#pragma unroll
            for (int i = 0; i < 4; ++i) v[b][i] = acc[b][mt][nt][rg * 4 + i];
          ep(eM + mt * 32 + rg * 8, wn * 64 + nt * 32 + eN, v);
        }
  }
}
template <int NB, class AL, class BL, class EP>
__device__ __forceinline__ void gemm_tile(int tid_, int K, AL al, BL bl, EP ep) { gemm_core<NB, false>(tid_, K, al, bl, ep); }

__device__ __forceinline__ void tile_mn(int T, int Mt, int Nt, int& mt, int& nt) {
  const int g = T / (Mt * 8), rem = T - g * Mt * 8;
  const int gs = (Nt - 8 * g) < 8 ? (Nt - 8 * g) : 8;
  mt = rem / gs; nt = 8 * g + rem % gs;
}

__device__ __forceinline__ void ada_range(const C& p, int t_first, int t_step, int t_end) {
  const int tid = p.tid;
  float* sc = (float*)smem;
  float* red = sc + 3072;
  const float* cc = p.in[5]; const float* cctx = p.in[6];
  for (int i = tid; i < 3072; i += 256) {
    int r = i >> 10, k = i & 1023;
    float c = (r == 0) ? cctx[k] : cc[(r - 1) * 1024 + k];
    sc[i] = c / (1.f + expf(-c));
  }
  __syncthreads();
  float* mod = (float*)(p.ws + WS_MOD);
  for (int t = t_first; t < t_end; t += t_step) {
    const int layer = t / 192, c0 = (t % 192) * 32;
    const int cg = tid & 7, kg = tid >> 3;
    const float* W = p.in[7] + (size_t)layer * 1024 * 6144 + c0 + cg * 4;
    float a[3][4];
#pragma unroll
    for (int r = 0; r < 3; ++r)
#pragma unroll
      for (int j = 0; j < 4; ++j) a[r][j] = 0.f;
#pragma unroll 8
    for (int kk = 0; kk < 32; ++kk) {
      const int k = kg * 32 + kk;
      const float4 w = *(const float4*)(W + (size_t)k * 6144);
#pragma unroll
      for (int r = 0; r < 3; ++r) {
        const float s = sc[r * 1024 + k];
        a[r][0] += s * w.x; a[r][1] += s * w.y; a[r][2] += s * w.z; a[r][3] += s * w.w;
      }
    }
#pragma unroll
    for (int r = 0; r < 3; ++r)
#pragma unroll
      for (int j = 0; j < 4; ++j) red[(kg * 3 + r) * 32 + cg * 4 + j] = a[r][j];
    __syncthreads();
    if (tid < 96) {
      const int r = tid >> 5, c = tid & 31;
      float s = 0.f;
#pragma unroll
      for (int g = 0; g < 32; ++g) s += red[(g * 3 + r) * 32 + c];
      mod[(size_t)(layer * 3 + r) * 6144 + c0 + c] = s + p.in[8][layer * 6144 + c0 + c];
    }
    __syncthreads();
  }
}
__device__ __forceinline__ void ph_ada(const C& p) {
  const int tid = p.tid;
  ada_range(p, p.bid, p.nb, p.nb > 384 ? 192 : 384);
  if (p.bid == p.nb - 1) {
    float* tab = (float*)(p.ws + WS_ROPE);
    for (int i = tid; i < 1024; i += 256) {
      const int pos = i >> 4, f = i & 15;
      const float ang = (float)pos * powf(10000.f, -(float)f / 16.f);
      tab[i * 2] = cosf(ang); tab[i * 2 + 1] = sinf(ang);
    }
  }
}

__device__ __forceinline__ void moe_combine_row(const C& p, int tok, int ml, int lane, float4 (&xv)[4]) {
  const int* SEL = (const int*)(p.ws + WS_SEL);
  const float* aff = (const float*)(p.ws + WS_AFF);
  const float* mod = (const float*)(p.ws + WS_MOD);
  const bf16_t* YE = (const bf16_t*)(p.ws + WS_YE);
  const int grp = tok >= NPR, nloc = tok - grp * NPR;
  float4 acc[4];
#pragma unroll
  for (int i = 0; i < 4; ++i) acc[i] = make_float4(0.f, 0.f, 0.f, 0.f);
  int sl[16]; float gts[16];
#pragma unroll
  for (int q = 0; q < 4; ++q) { const int4 v = *(const int4*)(SEL + tok * 16 + q * 4); sl[q * 4] = v.x; sl[q * 4 + 1] = v.y; sl[q * 4 + 2] = v.z; sl[q * 4 + 3] = v.w; }
#pragma unroll
  for (int e = 0; e < 16; ++e) gts[e] = aff[(size_t)(grp * 16 + e) * 4096 + nloc];
#pragma unroll
  for (int e = 0; e < 16; ++e) {
    const int slot = sl[e];
    if (slot >= 0) {
      const float gt = gts[e];
      const bf16_t* ye = YE + (size_t)(e * 768 + slot) * 1024;
#pragma unroll
      for (int i = 0; i < 4; ++i) {
        const uint2 w = *(const uint2*)(ye + (i * 64 + lane) * 4);
        acc[i].x += gt * __uint_as_float(w.x << 16); acc[i].y += gt * __uint_as_float(w.x & 0xffff0000u);
        acc[i].z += gt * __uint_as_float(w.y << 16); acc[i].w += gt * __uint_as_float(w.y & 0xffff0000u);
      }
    }
  }
  const float* g5 = mod + (size_t)(ml * 3 + modrow(tok)) * 6144 + 5 * 1024;
#pragma unroll
  for (int i = 0; i < 4; ++i) {
    const float4 gv = *(const float4*)(g5 + (i * 64 + lane) * 4);
    xv[i].x += gv.x * acc[i].x; xv[i].y += gv.y * acc[i].y; xv[i].z += gv.z * acc[i].z; xv[i].w += gv.w * acc[i].w;
  }
}

template <bool ROUTER>
__device__ __forceinline__ void ph_prep(const C& p, bool from_inputs, const float* g, int layer, int slot_shift, const float* rw) {
  const int tid = p.tid, lane = tid & 63, wave = tid >> 6;
  const float* mod = (const float*)(p.ws + WS_MOD);
  const float* xcur = (const float*)(p.ws + WS_XCUR);
  bf16_t* H = (bf16_t*)(p.ws + WS_H);
  float* aff = (float*)(p.ws + WS_AFF);
  for (int tok = p.bid * 4 + wave; tok < NTOK; tok += p.nb * 4) {
    const float* x = from_inputs ? (tok < NPR ? p.in[0] + (size_t)tok * DM : p.in[1] + (size_t)(tok - NPR) * DM) : xcur + (size_t)tok * DM;
    const int mr = modrow(tok);
    const float* sh = mod + (size_t)(layer * 3 + mr) * 6144 + slot_shift * 1024;
    const float* scl = sh + 1024;
    float4 xv[4];
    float ss = 0.f;
#pragma unroll
    for (int i = 0; i < 4; ++i) xv[i] = *(const float4*)(x + (i * 64 + lane) * 4);
    if (!ROUTER && !from_inputs) {
      moe_combine_row(p, tok, 0, lane, xv);
      float* xw = (float*)(p.ws + WS_XCUR) + (size_t)tok * DM;
#pragma unroll
      for (int i = 0; i < 4; ++i) *(float4*)(xw + (i * 64 + lane) * 4) = xv[i];
    }
    if (ROUTER) { if (lane < 16) ((int*)(p.ws + WS_SEL))[tok * 16 + lane] = -1; }
#pragma unroll
    for (int i = 0; i < 4; ++i) ss += xv[i].x * xv[i].x + xv[i].y * xv[i].y + xv[i].z * xv[i].z + xv[i].w * xv[i].w;
    ss = wave_sum(ss, lane);
    const float rinv = rsqrtf(ss * (1.f / 1024.f) + RMS_EPS);
    float lg[16];
    if (ROUTER) {
#pragma unroll
      for (int e = 0; e < 16; ++e) lg[e] = 0.f;
    }
#pragma unroll
    for (int i = 0; i < 4; ++i) {
      const int d = (i * 64 + lane) * 4;
      const float4 gv = *(const float4*)(g + d), sv = *(const float4*)(sh + d), cv = *(const float4*)(scl + d);
      float h[4];
      h[0] = xv[i].x * rinv * gv.x * (1.f + cv.x) + sv.x;
      h[1] = xv[i].y * rinv * gv.y * (1.f + cv.y) + sv.y;
      h[2] = xv[i].z * rinv * gv.z * (1.f + cv.z) + sv.z;
      h[3] = xv[i].w * rinv * gv.w * (1.f + cv.w) + sv.w;
      uint2 o; o.x = pk2(h[0], h[1]); o.y = pk2(h[2], h[3]);
      *(uint2*)(H + (size_t)tok * DM + d) = o;
      if (ROUTER) {
#pragma unroll
        for (int j = 0; j < 4; ++j) {
          const float4* rr = (const float4*)(rw + (size_t)(d + j) * 16);
#pragma unroll
          for (int q = 0; q < 4; ++q) {
            const float4 w = rr[q];
            lg[q * 4 + 0] += h[j] * w.x; lg[q * 4 + 1] += h[j] * w.y; lg[q * 4 + 2] += h[j] * w.z; lg[q * 4 + 3] += h[j] * w.w;
          }
        }
      }
    }
    if (ROUTER) {
      float mx = -1e30f;
#pragma unroll
      for (int e = 0; e < 16; ++e) { lg[e] = wave_sum(lg[e], lane); mx = fmaxf(mx, lg[e]); }
      float se = 0.f;
#pragma unroll
      for (int e = 0; e < 16; ++e) { lg[e] = expf(lg[e] - mx); se += lg[e]; }
      const float inv = 1.f / se;
      const int grp = tok >= NPR, nloc = tok - grp * NPR;
      float mine = 0.f;
#pragma unroll
      for (int e = 0; e < 16; ++e) mine = (lane == e) ? lg[e] * inv : mine;
      if (lane < 16) aff[(size_t)(grp * 16 + lane) * 4096 + nloc] = mine;
    }
  }
}

__device__ __forceinline__ void ph_router(const C& p, const float* g, int layer, const float* rw) {
  const int tid = p.tid, lane = tid & 63, wave = tid >> 6;
  const float* mod = (const float*)(p.ws + WS_MOD);
  const float* xcur = (const float*)(p.ws + WS_XCUR);
  bf16_t* H = (bf16_t*)(p.ws + WS_H);
  float* aff = (float*)(p.ws + WS_AFF);
  int* SEL = (int*)(p.ws + WS_SEL);
  for (int base = (p.bid * 4 + wave) * 3; base < NTOK; base += p.nb * 12) {
    float rinv[3]; const float* sh[3];
#pragma unroll
    for (int j = 0; j < 3; ++j) {
      const int tok = base + j;
      const float* x = xcur + (size_t)tok * DM;
      float ss = 0.f;
#pragma unroll
      for (int i = 0; i < 4; ++i) { const float4 v = *(const float4*)(x + (i * 64 + lane) * 4); ss += v.x * v.x + v.y * v.y + v.z * v.z + v.w * v.w; }
      ss = wave_sum(ss, lane);
      rinv[j] = rsqrtf(ss * (1.f / 1024.f) + RMS_EPS);
      sh[j] = mod + (size_t)(layer * 3 + modrow(tok)) * 6144 + 3 * 1024;
      if (lane < 16) SEL[tok * 16 + lane] = -1;
    }
    float lg[3][16];
#pragma unroll
    for (int j = 0; j < 3; ++j)
#pragma unroll
      for (int e = 0; e < 16; ++e) lg[j][e] = 0.f;
#pragma unroll 1
    for (int i = 0; i < 4; ++i) {
      const int d = (i * 64 + lane) * 4;
      const float4 gv = *(const float4*)(g + d);
      float h[3][4];
#pragma unroll
      for (int j = 0; j < 3; ++j) {
        const float4 xq = *(const float4*)(xcur + (size_t)(base + j) * DM + d);
        const float4 sv = *(const float4*)(sh[j] + d), cv = *(const float4*)(sh[j] + 1024 + d);
        h[j][0] = xq.x * rinv[j] * gv.x * (1.f + cv.x) + sv.x;
        h[j][1] = xq.y * rinv[j] * gv.y * (1.f + cv.y) + sv.y;
        h[j][2] = xq.z * rinv[j] * gv.z * (1.f + cv.z) + sv.z;
        h[j][3] = xq.w * rinv[j] * gv.w * (1.f + cv.w) + sv.w;
        uint2 o; o.x = pk2(h[j][0], h[j][1]); o.y = pk2(h[j][2], h[j][3]);
        *(uint2*)(H + (size_t)(base + j) * DM + d) = o;
      }
#pragma unroll
      for (int jj = 0; jj < 4; ++jj) {
        const float4* rr = (const float4*)(rw + (size_t)(d + jj) * 16);
#pragma unroll
        for (int q = 0; q < 4; ++q) {
          const float4 w = rr[q];
#pragma unroll
          for (int j = 0; j < 3; ++j) {
            lg[j][q * 4 + 0] += h[j][jj] * w.x; lg[j][q * 4 + 1] += h[j][jj] * w.y; lg[j][q * 4 + 2] += h[j][jj] * w.z; lg[j][q * 4 + 3] += h[j][jj] * w.w;
          }
        }
      }
    }
#pragma unroll
    for (int j = 0; j < 3; ++j) {
      const int tok = base + j;
      float mx = -1e30f;
#pragma unroll
      for (int e = 0; e < 16; ++e) { lg[j][e] = wave_sum(lg[j][e], lane); mx = fmaxf(mx, lg[j][e]); }
      float se = 0.f;
#pragma unroll
      for (int e = 0; e < 16; ++e) { lg[j][e] = expf(lg[j][e] - mx); se += lg[j][e]; }
      const float inv = 1.f / se;
      const int grp = tok >= NPR, nloc = tok - grp * NPR;
      float mine = 0.f;
#pragma unroll
      for (int e = 0; e < 16; ++e) mine = (lane == e) ? lg[j][e] * inv : mine;
      if (lane < 16) aff[(size_t)(grp * 16 + lane) * 4096 + nloc] = mine;
    }
  }
}

__device__ __forceinline__ void ph_gemm_in0(const C& p) {
  const bf16_t* H = (const bf16_t*)(p.ws + WS_H);
  const float* W = p.in[11];
  float* Z = (float*)(p.ws + WS_Z);
  for (int t = p.vb; t < 48 * 27; t += p.nb) {
    int mt_, nt_; tile_mn(t, 48, 27, mt_, nt_);
    const int m0 = mt_ * 128, n0 = nt_ * 128;
    gemm_tile<1>(p.tid, 1024,
      [=](int m, int k) { return *(const uint4*)(H + (size_t)(m0 + m) * DM + k); },
      [=](int, int k, int n) { return ldg4(W, (unsigned)(k * IN0C + n0 + n)); },
      [=](int m, int n, const float (&v)[1][4]) {
#pragma unroll
        for (int i = 0; i < 4; ++i) Z[(size_t)(m0 + m + i) * IN0C + n0 + n] = v[0][i];
      });
  }
}

__device__ __forceinline__ void ph_mix(const C& p) {
  const int tid = p.tid, lane = tid & 63, wave = tid >> 6;
  const float* Z = (const float*)(p.ws + WS_Z);
  float* ZM = (float*)(p.ws + WS_ZM);
  float* OA = (float*)(p.ws + WS_OPSA);
  bf16_t* YC = (bf16_t*)(p.ws + WS_YCAT);
  const float* cw = p.in[12]; const float* mu = p.in[13]; const float* kk_w = p.in[19];
  for (int tok = p.bid * 4 + wave; tok < NTOK; tok += p.nb * 4) {
    int t, T;
    if (tok < NPR) { t = tok & 255; T = 256; } else { t = (tok - NPR) & 1023; T = 1024; }
    const bool hasL = t > 0, hasR = t < T - 1;
    const float* zc = Z + (size_t)tok * IN0C;
    const float* zl = zc - IN0C; const float* zr = zc + IN0C;
    {
      const int c = lane * 8;
      float o[8];
#pragma unroll
      for (int q = 0; q < 2; ++q) {
        const int cq = c + q * 4;
        const float4 gb = *(const float4*)(zc + cq);
        const float4 gc = *(const float4*)(zc + 512 + cq), xa = *(const float4*)(zc + 1024 + cq);
        float4 ul = make_float4(0.f, 0.f, 0.f, 0.f), ur = ul;
        if (hasL) { const float4 a = *(const float4*)(zl + 512 + cq), b = *(const float4*)(zl + 1024 + cq); ul = make_float4(a.x * b.x, a.y * b.y, a.z * b.z, a.w * b.w); }
        if (hasR) { const float4 a = *(const float4*)(zr + 512 + cq), b = *(const float4*)(zr + 1024 + cq); ur = make_float4(a.x * b.x, a.y * b.y, a.z * b.z, a.w * b.w); }
        const float4 w0 = *(const float4*)(cw + cq), w1 = *(const float4*)(cw + 512 + cq), w2 = *(const float4*)(cw + 1024 + cq);
        o[q * 4 + 0] = gb.x * (w0.x * ul.x + w1.x * gc.x * xa.x + w2.x * ur.x);
        o[q * 4 + 1] = gb.y * (w0.y * ul.y + w1.y * gc.y * xa.y + w2.y * ur.y);
        o[q * 4 + 2] = gb.z * (w0.z * ul.z + w1.z * gc.z * xa.z + w2.z * ur.z);
        o[q * 4 + 3] = gb.w * (w0.w * ul.w + w1.w * gc.w * xa.w + w2.w * ur.w);
      }
      uint4 w; w.x = pk2(o[0], o[1]); w.y = pk2(o[2], o[3]); w.z = pk2(o[4], o[5]); w.w = pk2(o[6], o[7]);
      *(uint4*)(YC + (size_t)tok * DM + c) = w;
    }
#pragma unroll
    for (int i = 0; i < 8; ++i) {
      const int c = i * 256 + lane * 4;
      if (c < ZMC) {
        const float4 a = *(const float4*)(zc + 1536 + c);
        float4 l = make_float4(0.f, 0.f, 0.f, 0.f), r = l;
        if (hasL) l = *(const float4*)(zl + 1536 + c);
        if (hasR) r = *(const float4*)(zr + 1536 + c);
        const float4 m = *(const float4*)(mu + c);
        float4 o;
        o.x = a.x + m.x * (0.5f * (l.x + r.x) - a.x);
        o.y = a.y + m.y * (0.5f * (l.y + r.y) - a.y);
        o.z = a.z + m.z * (0.5f * (l.z + r.z) - a.z);
        o.w = a.w + m.w * (0.5f * (l.w + r.w) - a.w);
        *(float4*)(ZM + (size_t)tok * ZMC + c) = o;
        if (i < 2) {
          const int h = c >> 6, j = c & 63;
          *(float4*)(OA + ((size_t)(tok * 8 + h) * 2 + 1) * 64 + j) = o;
        } else if (i < 4) {
          const int ck = c - 512;
          const float4 kw = *(const float4*)(kk_w + ck);
          float4 q = make_float4(o.x * kw.x, o.y * kw.y, o.z * kw.z, o.w * kw.w);
          float ss = q.x * q.x + q.y * q.y + q.z * q.z + q.w * q.w;
          ss += swz<1>(ss); ss += swz<2>(ss); ss += swz<4>(ss); ss += swz<8>(ss);
          const float rn = -rsqrtf(fmaxf(ss, 1e-12f));
          q.x *= rn; q.y *= rn; q.z *= rn; q.w *= rn;
          const int h = ck >> 6, j = ck & 63;
          *(float4*)(OA + ((size_t)(tok * 8 + h) * 2 + 0) * 64 + j) = q;
        }
      }
    }
  }
}

__device__ __forceinline__ void ph_lora(const C& p) {
  const float* ZM = (const float*)(p.ws + WS_ZM);
  const float* OA = (const float*)(p.ws + WS_OPSA);
  float* OB = (float*)(p.ws + WS_OPSB);
  float* GG = (float*)(p.ws + WS_GG);
  for (int t = p.vb; t < 960; t += p.nb) {
    const int g = t / 192, rem = t % 192;
    const int m0 = (rem >> 2) * 128, n0 = (rem & 3) * 128;
    if (g < 2) {
      const int d = g;
      const float* W = p.in[15] + (size_t)d * 64 * 512;
      const float* w0 = p.in[14] + d * 512;
      gemm_tile<1>(p.tid, 64,
        [=](int m, int k) {
          const float* s = ZM + (size_t)(m0 + m) * ZMC + 1536 + d * 64 + k;
          const float4 a = *(const float4*)s, b = *(const float4*)(s + 4);
          uint4 o; o.x = pk2(ftanh_(a.x), ftanh_(a.y)); o.y = pk2(ftanh_(a.z), ftanh_(a.w)); o.z = pk2(ftanh_(b.x), ftanh_(b.y)); o.w = pk2(ftanh_(b.z), ftanh_(b.w));
          return o; },
        [=](int, int k, int n) { return ldg4(W, (unsigned)(k * 512 + n0 + n)); },
        [=](int m, int n, const float (&v)[1][4]) {
          const int nn = n0 + n, h = nn >> 6, j = nn & 63;
          const float b0 = w0[nn];
#pragma unroll
          for (int i = 0; i < 4; ++i) {
            const int tok = m0 + m + i;
            OB[(((size_t)d * NTOK + tok) * 8 + h) * 192 + j] = __builtin_amdgcn_exp2f((-DECAY_SCALE * 1.4426950408889634f) * fsigmoid_(b0 + v[0][i]));
          }
        });
    } else if (g < 4) {
      const int d = g - 2;
      const float* W = p.in[17] + (size_t)d * 64 * 512;
      const float* a0 = p.in[16] + d * 512;
      const float* ka = p.in[20];
      gemm_tile<1>(p.tid, 64,
        [=](int m, int k) {
          const float* s = ZM + (size_t)(m0 + m) * ZMC + 1664 + d * 64 + k;
          const float4 a = *(const float4*)s, b = *(const float4*)(s + 4);
          uint4 o; o.x = pk2(a.x, a.y); o.y = pk2(a.z, a.w); o.z = pk2(b.x, b.y); o.w = pk2(b.z, b.w);
          return o; },
        [=](int, int k, int n) { return ldg4(W, (unsigned)(k * 512 + n0 + n)); },
        [=](int m, int n, const float (&v)[1][4]) {
          const int nn = n0 + n, h = nn >> 6, j = nn & 63;
          const float b0 = a0[nn];
#pragma unroll
          for (int i = 0; i < 4; ++i) {
            const int tok = m0 + m + i;
            OB[(((size_t)d * NTOK + tok) * 8 + h) * 192 + 64 + j] = fsigmoid_(b0 + v[0][i]);
          }
        });
    } else {
      const float* W = p.in[18];
      gemm_tile<1>(p.tid, 128,
        [=](int m, int k) {
          const float* s = ZM + (size_t)(m0 + m) * ZMC + 1792 + k;
          const float4 a = *(const float4*)s, b = *(const float4*)(s + 4);
          uint4 o; o.x = pk2(fsigmoid_(a.x), fsigmoid_(a.y)); o.y = pk2(fsigmoid_(a.z), fsigmoid_(a.w)); o.z = pk2(fsigmoid_(b.x), fsigmoid_(b.y)); o.w = pk2(fsigmoid_(b.z), fsigmoid_(b.w));
          return o; },
        [=](int, int k, int n) { return ldg4(W, (unsigned)(k * 512 + n0 + n)); },
        [=](int m, int n, const float (&v)[1][4]) {
#pragma unroll
          for (int i = 0; i < 4; ++i) GG[(size_t)(m0 + m + i) * 512 + n0 + n] = v[0][i];
        });
    }
  }
}

#define CH_L 128
__device__ __forceinline__ int pq_entry(int ch, int c) { return ch < 32 ? ch * 8 + c : 256 + (ch - 32) * 2 + c; }
__device__ __forceinline__ void ph_scan(const C& p) {
  const int lane = p.tid & 63;
  const int wave = __builtin_amdgcn_readfirstlane(p.tid >> 6);
  const float* ZM = (const float*)(p.ws + WS_ZM);
  const float* OA = (const float*)(p.ws + WS_OPSA);
  const float* OB = (const float*)(p.ws + WS_OPSB);
  float* YD = (float*)(p.ws + WS_YD);
  float* UD = (float*)(p.ws + WS_UD);
  float* PQ = (float*)(p.ws + WS_PQ);
  const int d = wave >> 1, ident = wave & 1;
  for (int it = p.bid; it < 384; it += p.nb) {
    int b, h, c, T, tok0, ch;
    if (it < 128) { b = it >> 6; h = (it >> 3) & 7; c = it & 7; T = 1024; tok0 = NPR + b * 1024; ch = (b * 8 + h) * 2 + d; }
    else { const int i2 = it - 128; b = i2 >> 4; h = (i2 >> 1) & 7; c = i2 & 1; T = 256; tok0 = b * 256; ch = 32 + (b * 8 + h) * 2 + d; }
    if (ident && c == 0) continue;
    float S[64];
    if (ident) {
#pragma unroll
      for (int k = 0; k < 64; ++k) S[k] = (k == lane) ? 1.f : 0.f;
    } else if (c == 0 && it < 128) {
      const float* s0 = p.in[2] + ((size_t)((b * 2 + d) * 8 + h) * 64 + lane) * 64;
#pragma unroll
      for (int k = 0; k < 64; k += 4) { const float4 v = *(const float4*)(s0 + k); S[k] = v.x; S[k + 1] = v.y; S[k + 2] = v.z; S[k + 3] = v.w; }
    } else {
#pragma unroll
      for (int k = 0; k < 64; ++k) S[k] = 0.f;
    }
    const int tinc = d ? -1 : 1;
    const int tokA = tok0 + (d ? T - 1 - c * CH_L : c * CH_L);
    float* yout = ident ? UD : YD;
    float ob[4][5], vb[4];
    const float ka_l = p.in[20][h * 64 + lane];
    auto fetch = [&](int j, int sidx) {
      const int sc = sidx < CH_L ? sidx : CH_L - 1;
      const int tk = tokA + sc * tinc;
      const float* pa = OA + (size_t)(tk * 8 + h) * 128 + lane;
      const float* pb = OB + (((size_t)d * NTOK + tk) * 8 + h) * 192 + lane;
      const float nk_ = pa[0], a_ = pb[64], kp_ = ZM[(size_t)tk * ZMC + 512 + h * 64 + lane];
      ob[j][0] = nk_; ob[j][1] = pa[64]; ob[j][2] = pb[0];
      ob[j][3] = -nk_ * a_;
      ob[j][4] = kp_ * (1.f + (a_ - 1.f) * ka_l);
      vb[j] = ident ? 0.f : ZM[(size_t)tk * ZMC + 1024 + h * 64 + lane];
    };
#pragma unroll
    for (int j = 0; j < 4; ++j) fetch(j, j);
#pragma unroll 1
    for (int s0 = 0; s0 < CH_L; s0 += 4) {
#pragma unroll
      for (int j = 0; j < 4; ++j) {
        const int tok = tokA + (s0 + j) * tinc;
        const int i_nkk = __builtin_bit_cast(int, ob[j][0]), i_r = __builtin_bit_cast(int, ob[j][1]);
        const int i_w = __builtin_bit_cast(int, ob[j][2]), i_b = __builtin_bit_cast(int, ob[j][3]), i_kd = __builtin_bit_cast(int, ob[j][4]);
        const float vv = vb[j];
        float sa0 = 0.f, sa1 = 0.f;
#pragma unroll
        for (int k = 0; k < 64; k += 2) {
          sa0 += S[k] * __builtin_bit_cast(float, __builtin_amdgcn_readlane(i_nkk, k));
          sa1 += S[k + 1] * __builtin_bit_cast(float, __builtin_amdgcn_readlane(i_nkk, k + 1));
        }
        const float sa = sa0 + sa1;
        float y0 = 0.f, y1 = 0.f;
#pragma unroll
        for (int k = 0; k < 64; k += 2) {
          S[k] = S[k] * __builtin_bit_cast(float, __builtin_amdgcn_readlane(i_w, k))
               + (sa * __builtin_bit_cast(float, __builtin_amdgcn_readlane(i_b, k)) + vv * __builtin_bit_cast(float, __builtin_amdgcn_readlane(i_kd, k)));
          S[k + 1] = S[k + 1] * __builtin_bit_cast(float, __builtin_amdgcn_readlane(i_w, k + 1))
               + (sa * __builtin_bit_cast(float, __builtin_amdgcn_readlane(i_b, k + 1)) + vv * __builtin_bit_cast(float, __builtin_amdgcn_readlane(i_kd, k + 1)));
          y0 += S[k] * __builtin_bit_cast(float, __builtin_amdgcn_readlane(i_r, k));
          y1 += S[k + 1] * __builtin_bit_cast(float, __builtin_amdgcn_readlane(i_r, k + 1));
        }
        yout[((size_t)d * NTOK + tok) * 512 + h * 64 + lane] = y0 + y1;
        fetch(j, s0 + j + 4);
      }
    }
    float* so = PQ + ((size_t)pq_entry(ch, c) * 2 + (ident ? 0 : 1)) * 4096 + lane * 64;
#pragma unroll
    for (int k = 0; k < 64; k += 4) *(float4*)(so + k) = make_float4(S[k], S[k + 1], S[k + 2], S[k + 3]);
  }
  if (p.nb > 384 && p.bid >= 384) ada_range(p, 192 + (p.bid - 384), p.nb - 384, 384);
}

__device__ __forceinline__ void ph_scanfix(const C& p) {
  const int tid = p.tid, lane = tid & 63, wave = tid >> 6;
  float* Sa = (float*)smem;
  float* Sb = Sa + 64 * 65;
  float* Pl = Sb + 64 * 65;
  float* YD = (float*)(p.ws + WS_YD);
  const float* UD = (const float*)(p.ws + WS_UD);
  const float* PQ = (const float*)(p.ws + WS_PQ);
  for (int it = p.bid; it < 480; it += p.nb) {
    int ch, c, nch;
    if (it < 224) { ch = it / 7; c = 1 + it % 7; nch = 8; } else { ch = 32 + (it - 224); c = 1; nch = 2; }
    int b, h, d, T, tok0;
    if (ch < 32) { b = ch >> 4; h = (ch >> 1) & 7; d = ch & 1; T = 1024; tok0 = NPR + b * 1024; }
    else { const int c2 = ch - 32; b = c2 >> 4; h = (c2 >> 1) & 7; d = c2 & 1; T = 256; tok0 = b * 256; }
    { const float* q0 = PQ + ((size_t)pq_entry(ch, 0) * 2 + 1) * 4096;
      for (int i = tid; i < 4096; i += 256) Sa[(i >> 6) * 65 + (i & 63)] = q0[i]; }
    float* cur = Sa; float* nxt = Sb;
    const bool emit = (ch >= 32) && (c == nch - 1);
    const int nmul = (c - 1) + (emit ? 1 : 0);
    const int v = tid >> 2, kq = (tid & 3) * 16;
    for (int m = 0; m < nmul; ++m) {
      const int cc = 1 + m;
      const float* Pg = PQ + ((size_t)pq_entry(ch, cc) * 2 + 0) * 4096;
      const float* Qg = Pg + 4096;
      __syncthreads();
      for (int i = tid; i < 1024; i += 256) *(float4*)(Pl + i * 4) = *(const float4*)(Pg + i * 4);
      __syncthreads();
      float acc[16];
#pragma unroll
      for (int j = 0; j < 16; j += 4) { const float4 q = *(const float4*)(Qg + v * 64 + kq + j); acc[j] = q.x; acc[j + 1] = q.y; acc[j + 2] = q.z; acc[j + 3] = q.w; }
      for (int i = 0; i < 64; ++i) {
        const float a = cur[v * 65 + i];
#pragma unroll
        for (int j = 0; j < 16; j += 4) {
          const float4 pv = *(const float4*)(Pl + i * 64 + kq + j);
          acc[j] += a * pv.x; acc[j + 1] += a * pv.y; acc[j + 2] += a * pv.z; acc[j + 3] += a * pv.w;
        }
      }
      if (emit && m == nmul - 1) {
        float* so = p.out + O_ST + ((size_t)((b * 2 + d) * 8 + h) * 64 + v) * 64 + kq;
#pragma unroll
        for (int j = 0; j < 16; j += 4) *(float4*)(so + j) = make_float4(acc[j], acc[j + 1], acc[j + 2], acc[j + 3]);
      } else {
#pragma unroll
        for (int j = 0; j < 16; ++j) nxt[v * 65 + kq + j] = acc[j];
        float* t = cur; cur = nxt; nxt = t;
      }
    }
    __syncthreads();
    float sr[64];
#pragma unroll
    for (int i = 0; i < 64; ++i) sr[i] = cur[lane * 65 + i];
    __syncthreads();
    float* Ul = Sb + wave * 2048;
    const int tinc = d ? -1 : 1;
    const int tokA = tok0 + (d ? T - 1 - c * CH_L : c * CH_L);
    {
      float uv[32];
#pragma unroll
      for (int s = 0; s < 32; ++s) uv[s] = UD[((size_t)d * NTOK + (tokA + (wave * 32 + s) * tinc)) * 512 + h * 64 + lane];
#pragma unroll
      for (int s = 0; s < 32; ++s) Ul[s * 64 + lane] = uv[s];
    }
    __syncthreads();
    float yv[32];
#pragma unroll
    for (int s = 0; s < 32; ++s) yv[s] = YD[((size_t)d * NTOK + (tokA + (wave * 32 + s) * tinc)) * 512 + h * 64 + lane];
#pragma unroll
    for (int s = 0; s < 32; ++s) {
      const int tok = tokA + (wave * 32 + s) * tinc;
      float a0 = 0.f, a1 = 0.f;
#pragma unroll
      for (int i = 0; i < 64; i += 4) {
        const float4 u = *(const float4*)(Ul + s * 64 + i);
        a0 += sr[i] * u.x; a1 += sr[i + 1] * u.y; a0 += sr[i + 2] * u.z; a1 += sr[i + 3] * u.w;
      }
      YD[((size_t)d * NTOK + tok) * 512 + h * 64 + lane] = yv[s] + (a0 + a1);
    }
    __syncthreads();
  }
}

__device__ __forceinline__ void ph_post(const C& p) {
  const int tid = p.tid, lane = tid & 63, wave = tid >> 6;
  const float* ZM = (const float*)(p.ws + WS_ZM);
  const float* YD = (const float*)(p.ws + WS_YD);
  const float* GG = (const float*)(p.ws + WS_GG);
  bf16_t* YC = (bf16_t*)(p.ws + WS_YCAT);
  const float* rk = p.in[21]; const float* lnw = p.in[22]; const float* lnb = p.in[23];
  for (int tok = p.bid * 4 + wave; tok < NTOK; tok += p.nb * 4) {
    const int c = lane * 8;
    float y[8], r[8], k[8], v[8], g[8];
#pragma unroll
    for (int q = 0; q < 2; ++q) {
      const float4 a = *(const float4*)(YD + (size_t)tok * 512 + c + q * 4), b = *(const float4*)(YD + ((size_t)NTOK + tok) * 512 + c + q * 4);
      y[q * 4] = a.x + b.x; y[q * 4 + 1] = a.y + b.y; y[q * 4 + 2] = a.z + b.z; y[q * 4 + 3] = a.w + b.w;
      const float4 rr = *(const float4*)(ZM + (size_t)tok * ZMC + c + q * 4), kk = *(const float4*)(ZM + (size_t)tok * ZMC + 512 + c + q * 4), vv = *(const float4*)(ZM + (size_t)tok * ZMC + 1024 + c + q * 4);
      r[q * 4] = rr.x; r[q * 4 + 1] = rr.y; r[q * 4 + 2] = rr.z; r[q * 4 + 3] = rr.w;
      k[q * 4] = kk.x; k[q * 4 + 1] = kk.y; k[q * 4 + 2] = kk.z; k[q * 4 + 3] = kk.w;
      v[q * 4] = vv.x; v[q * 4 + 1] = vv.y; v[q * 4 + 2] = vv.z; v[q * 4 + 3] = vv.w;
      const float4 gg = *(const float4*)(GG + (size_t)tok * 512 + c + q * 4);
      g[q * 4] = gg.x; g[q * 4 + 1] = gg.y; g[q * 4 + 2] = gg.z; g[q * 4 + 3] = gg.w;
    }
    float sm = 0.f, bn = 0.f;
#pragma unroll
    for (int i = 0; i < 8; ++i) { sm += y[i]; bn += r[i] * k[i] * rk[c + i]; }
    sm += swz<1>(sm); sm += swz<2>(sm); sm += swz<4>(sm);
    bn += swz<1>(bn); bn += swz<2>(bn); bn += swz<4>(bn);
    const float mean = sm * (1.f / 64.f);
    float vr = 0.f;
#pragma unroll
    for (int i = 0; i < 8; ++i) { const float dd = y[i] - mean; vr += dd * dd; }
    vr += swz<1>(vr); vr += swz<2>(vr); vr += swz<4>(vr);
    const float rs = rsqrtf(vr * (1.f / 64.f) + GN_EPS);
    float o[8];
#pragma unroll
    for (int i = 0; i < 8; ++i) o[i] = ((y[i] - mean) * rs * lnw[c + i] + lnb[c + i] + bn * v[i]) * g[i];
    uint4 w; w.x = pk2(o[0], o[1]); w.y = pk2(o[2], o[3]); w.z = pk2(o[4], o[5]); w.w = pk2(o[6], o[7]);
    *(uint4*)(YC + (size_t)tok * DM + 512 + c) = w;
  }
}

__device__ __forceinline__ void ph_gemm_out(const C& p, const float* W, int layer, bool from_inputs) {
  const bf16_t* A = (const bf16_t*)(p.ws + WS_YCAT);
  const float* mod = (const float*)(p.ws + WS_MOD);
  float* X = (float*)(p.ws + WS_XCUR);
  for (int t = p.vb; t < 48 * 8; t += p.nb) {
    int mt_, nt_; tile_mn(t, 48, 8, mt_, nt_);
    const int m0 = mt_ * 128, n0 = nt_ * 128;
    const float* gate = mod + (size_t)(layer * 3 + modrow(m0)) * 6144 + 2 * 1024;
    const float* xin = from_inputs ? (m0 < NPR ? p.in[0] + (size_t)m0 * DM : p.in[1] + (size_t)(m0 - NPR) * DM) : X + (size_t)m0 * DM;
    const float* xr_ = xin + (size_t)(p.tid >> 1) * DM + n0 + (p.tid & 1) * 64;
    const float t0_ = xr_[0], t1_ = xr_[32];
    gemm_tile<1>(p.tid, 1024,
      [=](int m, int k) { return *(const uint4*)(A + (size_t)(m0 + m) * DM + k); },
      [=](int, int k, int n) { return ldg4(W, (unsigned)(k * DM + n0 + n)); },
      [=](int m, int n, const float (&v)[1][4]) {
        const float gt = gate[n0 + n];
#pragma unroll
        for (int i = 0; i < 4; ++i) X[(size_t)(m0 + m + i) * DM + n0 + n] = xin[(size_t)(m + i) * DM + n0 + n] + gt * v[0][i];
      });
    asm volatile("" :: "v"(t0_), "v"(t1_));
  }
}

__device__ __forceinline__ void ph_topk(const C& p) {
  const int tid = p.tid;
  unsigned* keys = (unsigned*)smem;
  unsigned* hist = keys + 4096;
  unsigned* ctl = hist + 256;
  unsigned* gsum = ctl + 8;
  const float* aff = (const float*)(p.ws + WS_AFF);
  int* IDX = (int*)(p.ws + WS_IDX);
  int* SEL = (int*)(p.ws + WS_SEL);
  for (int it = p.bid; it < 32; it += p.nb) {
    const int grp = it >> 4, e = it & 15;
    const int n = grp ? NSA : NPR, cap = n >> 3;
    const float* a = aff + (size_t)(grp * 16 + e) * 4096;
    for (int i = tid; i < n; i += 256) keys[i] = __float_as_uint(a[i]);
    unsigned prefix = 0, mask = 0, need = cap;
    for (int pass = 0; pass < 4; ++pass) {
      const int shift = 24 - 8 * pass;
      hist[tid] = 0;
      __syncthreads();
      for (int i = tid; i < n; i += 256) { const unsigned k = keys[i]; if ((k & mask) == prefix) atomicAdd(&hist[(k >> shift) & 255u], 1u); }
      __syncthreads();
      if (tid < 16) {
        unsigned g = 0;
#pragma unroll
        for (int j = 0; j < 16; ++j) g += hist[tid * 16 + j];
        gsum[tid] = g;
      }
      __syncthreads();
      {
        const unsigned hb = hist[tid];
        const int g = tid >> 4, bl = tid & 15;
        unsigned cum = 0;
#pragma unroll
        for (int q = 1; q < 16; ++q) {
          const unsigned gv = gsum[(g + q) & 15], hv = hist[(tid & ~15) + ((bl + q) & 15)];
          cum += (g + q < 16) ? gv : 0u;
          cum += (bl + q < 16) ? hv : 0u;
        }
        if (cum < need && cum + hb >= need) { ctl[0] = tid; ctl[1] = need - cum; }
      }
      __syncthreads();
      prefix |= ctl[0] << shift; mask |= 255u << shift; need = ctl[1];
      __syncthreads();
    }
    if (tid == 0) { ctl[2] = 0; ctl[3] = 0; }
    __syncthreads();
    const unsigned T = prefix;
    for (int i = tid; i < n; i += 256) if (keys[i] == T) atomicAdd(&ctl[3], 1u);
    __syncthreads();
    const bool all_eq = ctl[3] == need;
    const int obase = e * 768 + (grp ? 512 : 0);
    for (int i = tid; i < n; i += 256) {
      const unsigned k = keys[i];
      bool sel = k > T;
      if (k == T) { if (all_eq) sel = true; else { unsigned rk = 0; for (int j = 0; j < i; ++j) rk += (keys[j] == T); sel = rk < need; } }
      if (sel) {
        const unsigned slot = atomicAdd(&ctl[2], 1u);
        IDX[obase + slot] = i + grp * NPR;
        SEL[(i + grp * NPR) * 16 + e] = (int)(obase - e * 768 + slot);
      }
    }
    __syncthreads();
  }
}

__device__ __forceinline__ void ph_moe_up(const C& p, int layer) {
  const bf16_t* H = (const bf16_t*)(p.ws + WS_H);
  const int* IDX = (const int*)(p.ws + WS_IDX);
  bf16_t* HID = (bf16_t*)(p.ws + WS_HID);
  for (int t = p.vb; t < 1536; t += p.nb) {
    const int e = t / 96, rem = t % 96, m0 = (rem % 6) * 128, n0 = (rem / 6) * 64;
    const float* W1 = p.in[32] + ((size_t)layer * 16 + e) * 1024 * 1024;
    const float* W3 = p.in[33] + ((size_t)layer * 16 + e) * 1024 * 1024;
    const int myrow = IDX[e * 768 + m0 + (p.tid >> 1)];
    const bf16_t* arow = H + (size_t)myrow * DM;
    gemm_core<1, true>(p.tid, 1024,
      [=](int, int k) { return *(const uint4*)(arow + k); },
      [=](int, int k, int n) { const int seg = n >> 5; return ldg4((seg & 1) ? W3 : W1, (unsigned)(k * 1024 + n0 + (seg >> 1) * 32 + (n & 31))); },
      [=](int m, int n, const float (&v)[2][4]) {
#pragma unroll
        for (int i = 0; i < 4; ++i) {
          const float a = v[0][i];
          HID[((size_t)e * 768 + m0 + m + i) * 1024 + n0 + n] = f2bf(a * fsigmoid_(a) * v[1][i]);
        }
      });
  }
}

__device__ __forceinline__ void ph_moe_down(const C& p, int layer) {
  const bf16_t* HID = (const bf16_t*)(p.ws + WS_HID);
  bf16_t* YE = (bf16_t*)(p.ws + WS_YE);
  for (int t = p.vb; t < 768; t += p.nb) {
    const int e = t / 48, rem = t % 48, m0 = (rem % 6) * 128, n0 = (rem / 6) * 128;
    const float* W2 = p.in[34] + ((size_t)layer * 16 + e) * 1024 * 1024;
    const bf16_t* A = HID + ((size_t)e * 768 + m0) * 1024;
    bf16_t* Y = YE + ((size_t)e * 768 + m0) * 1024 + n0;
    gemm_tile<1>(p.tid, 1024,
      [=](int m, int k) { return *(const uint4*)(A + (size_t)m * 1024 + k); },
      [=](int, int k, int n) { return ldg4(W2, (unsigned)(k * 1024 + n0 + n)); },
      [=](int m, int n, const float (&v)[1][4]) {
#pragma unroll
        for (int i = 0; i < 4; ++i) Y[(size_t)(m + i) * 1024 + n] = f2bf(v[0][i]);
      });
  }
}

__device__ __forceinline__ void ph_gemm_in1(const C& p) {
  const bf16_t* H = (const bf16_t*)(p.ws + WS_H);
  const float* W = p.in[25];
  float* Z1 = (float*)(p.ws + WS_Z1);
  for (int t = p.vb; t < 48 * 6; t += p.nb) {
    int mt_, nt_; tile_mn(t, 48, 6, mt_, nt_);
    const int m0 = mt_ * 128, n0 = nt_ * 128;
    gemm_tile<1>(p.tid, 1024,
      [=](int m, int k) { return *(const uint4*)(H + (size_t)(m0 + m) * DM + k); },
      [=](int, int k, int n) { return (n0 + n < IN1C) ? ldg4(W, (unsigned)(k * IN1C + n0 + n)) : make_float4(0.f, 0.f, 0.f, 0.f); },
      [=](int m, int n, const float (&v)[1][4]) {
        if (n0 + n < IN1C) {
#pragma unroll
          for (int i = 0; i < 4; ++i) Z1[(size_t)(m0 + m + i) * IN1C + n0 + n] = v[0][i];
        }
      });
  }
}

__device__ __forceinline__ int kofs(int seq) { return seq < 16 ? seq * 256 : 4096 + (seq - 16) * 1280; }
__device__ __forceinline__ void keyrow_geom(int row, int& seq, int& pos, int& nk) {
  if (row < NPR) { seq = row >> 8; pos = row & 255; nk = 256; }
  else if (row < NTOK) { seq = 16 + ((row - NPR) >> 10); pos = 256 + ((row - NPR) & 1023); nk = 1280; }
  else { seq = 16 + ((row - NTOK) >> 8); pos = (row - NTOK) & 255; nk = 1280; }
}

__device__ __forceinline__ int kfrag_off(int key, int d) { return (d >> 4) * 512 + ((d >> 3) & 1) * 256 + key * 8 + (d & 7); }

__device__ __forceinline__ void ph_mla_norm(const C& p) {
  const int tid = p.tid, lane = tid & 63, wave = tid >> 6;
  const float* Z1 = (const float*)(p.ws + WS_Z1);
  const float* tab = (const float*)(p.ws + WS_ROPE);
  bf16_t* CQN = (bf16_t*)(p.ws + WS_CQN);
  bf16_t* CKVN = (bf16_t*)(p.ws + WS_CKVN);
  bf16_t* KH = (bf16_t*)(p.ws + WS_KH);
  const float* qn = p.in[26]; const float* kvn = p.in[27];
  for (int row = p.bid * 4 + wave; row < NKROW; row += p.nb * 4) {
    if (row < NTOK) {
      const float* z = Z1 + (size_t)row * IN1C;
      float cq[6], ss = 0.f;
#pragma unroll
      for (int i = 0; i < 6; ++i) { cq[i] = z[i * 64 + lane]; ss += cq[i] * cq[i]; }
      ss = wave_sum(ss, lane);
      const float rq = rsqrtf(ss * (1.f / 384.f) + RMS_EPS);
#pragma unroll
      for (int i = 0; i < 6; ++i) CQN[(size_t)row * 384 + i * 64 + lane] = f2bf(cq[i] * rq * qn[i * 64 + lane]);
      float ck[4], s2 = 0.f;
#pragma unroll
      for (int i = 0; i < 4; ++i) { ck[i] = z[384 + i * 64 + lane]; s2 += ck[i] * ck[i]; }
      s2 = wave_sum(s2, lane);
      const float rk = rsqrtf(s2 * (1.f / 256.f) + RMS_EPS);
#pragma unroll
      for (int i = 0; i < 4; ++i) {
        const float o = ck[i] * rk * kvn[i * 64 + lane];
        CKVN[(size_t)row * 256 + i * 64 + lane] = f2bf(o);
        if (row < NPR) p.out[O_CKV + (size_t)row * 256 + i * 64 + lane] = o;
      }
      float kp = z[640 + lane];
      if (row < NPR) {
        p.out[O_KPE + (size_t)row * 64 + lane] = kp;
      } else {
        const int tt = (row - NPR) & 1023;
        const int grp = lane >> 5, idx = lane & 31, f = idx & 15;
        const int pos = grp ? (tt & 63) : (tt >> 6);
        const float cs = tab[(pos * 16 + f) * 2], sn = tab[(pos * 16 + f) * 2 + 1];
        const float pr = swz<16>(kp);
        kp = (idx < 16) ? (kp * cs - pr * sn) : (pr * sn + kp * cs);
      }
      { int seq, pos, nk; keyrow_geom(row, seq, pos, nk);
        const bf16_t kb = f2bf(kp);
#pragma unroll
        for (int hh = 0; hh < 8; ++hh) KH[((size_t)kofs(seq) * 8 + (size_t)hh * nk + (pos & ~31)) * 192 + kfrag_off(pos & 31, 128 + lane)] = kb; }
    } else {
      const int cr = row - NTOK;
      const float* c = p.in[3] + (size_t)cr * 256;
#pragma unroll
      for (int i = 0; i < 4; ++i) CKVN[(size_t)row * 256 + i * 64 + lane] = f2bf(c[i * 64 + lane]);
      { int seq, pos, nk; keyrow_geom(row, seq, pos, nk);
        const bf16_t kb = f2bf(p.in[4][(size_t)cr * 64 + lane]);
#pragma unroll
        for (int hh = 0; hh < 8; ++hh) KH[((size_t)kofs(seq) * 8 + (size_t)hh * nk + (pos & ~31)) * 192 + kfrag_off(pos & 31, 128 + lane)] = kb; }
    }
  }
}

__device__ __forceinline__ void ph_mla_qkv(const C& p) {
  const bf16_t* CQN = (const bf16_t*)(p.ws + WS_CQN);
  const bf16_t* CKVN = (const bf16_t*)(p.ws + WS_CKVN);
  const float* tab = (const float*)(p.ws + WS_ROPE);
  bf16_t* QB = (bf16_t*)(p.ws + WS_QBUF);
  bf16_t* KH = (bf16_t*)(p.ws + WS_KH);
  bf16_t* VT = (bf16_t*)(p.ws + WS_VT);
  const float* Wq = p.in[28]; const float* Wkv = p.in[29];
  for (int t = p.vb; t < 576 + 832; t += p.nb) {
    if (t < 576) {
      int mt_, nt_; tile_mn(t, 48, 12, mt_, nt_);
      const int m0 = mt_ * 128, n0 = nt_ * 128;
      gemm_tile<1>(p.tid, 384,
        [=](int m, int k) { return *(const uint4*)(CQN + (size_t)(m0 + m) * 384 + k); },
        [=](int, int k, int n) { return ldg4(Wq, (unsigned)(k * 1536 + n0 + n)); },
        [=](int m, int n, const float (&v)[1][4]) {
          const int nn = n0 + n;
          const int sub = (nn % 192) >> 5;
          float o[4] = {v[0][0], v[0][1], v[0][2], v[0][3]};
          if (m0 >= NPR && sub >= 4) {
            const int idx = nn & 31, f = idx & 15;
#pragma unroll
            for (int i = 0; i < 4; ++i) {
              const int tt = (m0 + m + i - NPR) & 1023;
              const int pos = (sub == 5) ? (tt & 63) : (tt >> 6);
              const float cs = tab[(pos * 16 + f) * 2], sn = tab[(pos * 16 + f) * 2 + 1];
              const float pr = swz<16>(o[i]);
              o[i] = (idx < 16) ? (o[i] * cs - pr * sn) : (pr * sn + o[i] * cs);
            }
          }
#pragma unroll
          for (int i = 0; i < 4; ++i) QB[(size_t)(m0 + m + i) * 1536 + nn] = f2bf(o[i]);
        });
    } else {
      const int t2 = t - 576;
      int mt_, nt_; tile_mn(t2, 52, 16, mt_, nt_);
      const int m0 = mt_ * 128, n0 = nt_ * 128;
      int seq, pos0, nk; keyrow_geom(m0, seq, pos0, nk);
      const int h = n0 >> 8;
      const bool isv = (n0 & 128) != 0;
      bf16_t* kdst0 = KH + ((size_t)kofs(seq) * 8 + (size_t)h * nk) * 192;
      bf16_t* vdst = VT + ((size_t)kofs(seq) * 8 + (size_t)h * nk) * 128;
      auto alkv = [=](int m, int k) { return *(const uint4*)(CKVN + (size_t)(m0 + m) * 256 + k); };
      auto blkv = [=](int, int k, int n) { return ldg4(Wkv, (unsigned)(k * 2048 + n0 + n)); };
      if (!isv) {
        gemm_tile<1>(p.tid, 256, alkv, blkv,
          [=](int m, int n, const float (&v)[1][4]) {
#pragma unroll
            for (int i = 0; i < 4; ++i) { const int pp = pos0 + m + i; kdst0[(size_t)(pp & ~31) * 192 + kfrag_off(pp & 31, n)] = f2bf(v[0][i]); }
          });
      } else {
        gemm_tile<1>(p.tid, 256, alkv, blkv,
          [=](int m, int n, const float (&v)[1][4]) {
            const int pos = pos0 + m;
            uint2 w; w.x = pk2(v[0][0], v[0][1]); w.y = pk2(v[0][2], v[0][3]);
            const int kk = pos & 31;
            *(uint2*)(vdst + (size_t)(pos >> 5) * 4096 + (((n >> 5) * 2 + (kk >> 4)) * 2 + ((kk >> 2) & 1)) * 256 + (n & 31) * 8 + ((kk >> 3) & 1) * 4) = w;
          });
      }
    }
  }
}

__device__ __forceinline__ void attn_item(const C& p, int seq, int hd, int qtok0, int tid) {
  const int lane = tid & 63, wave = tid >> 6, l31 = lane & 31, lh = lane >> 5;
  const bf16_t* QB = (const bf16_t*)(p.ws + WS_QBUF);
  const bf16_t* KH = (const bf16_t*)(p.ws + WS_KH);
  const bf16_t* VT = (const bf16_t*)(p.ws + WS_VT);
  bf16_t* OUT = (bf16_t*)(p.ws + WS_YCAT);
  float* Oacc = (float*)smem;
  float* sm_m = Oacc + 8192;
  float* sm_l = sm_m + 128;
  const int qt = wave & 1, khf = wave >> 1;
  const int nk = seq < 16 ? 256 : 1280;
  const int ntile = nk >> 5, tpw = ntile >> 1;
  const bf16_t* vt = VT + ((size_t)kofs(seq) * 8 + (size_t)hd * nk) * 128;
  const bf16_t* kh = KH + ((size_t)kofs(seq) * 8 + (size_t)hd * nk) * 192;
  bf16_t* Qs = (bf16_t*)(sm_l + 128);
#pragma unroll
  for (int i = 0; i < 6; ++i) {
    const int idx = tid + i * 256, row = idx / 24, c8 = (idx % 24) * 8;
    *(uint4*)&Qs[row * 200 + c8] = *(const uint4*)(QB + (size_t)(qtok0 + row) * 1536 + hd * 192 + c8);
  }
  __syncthreads();
  const bf16_t* qs = Qs + (qt * 32 + l31) * 200 + lh * 8;
  f32x16 oacc[4];
#pragma unroll
  for (int dt = 0; dt < 4; ++dt)
#pragma unroll
    for (int r = 0; r < 16; ++r) oacc[dt][r] = 0.f;
  float mrun = -1e30f, lrun = 0.f;
#pragma unroll 1
  for (int kt = khf * tpw; kt < (khf + 1) * tpw; ++kt) {
    bf16x8 kf[12]; uint4 vf[8];
    const bf16_t* kn = kh + (size_t)kt * 6144 + lh * 256 + l31 * 8;
#pragma unroll
    for (int ks = 0; ks < 12; ++ks) kf[ks] = *(const bf16x8*)(kn + ks * 512);
    const bf16_t* vp = vt + (size_t)kt * 4096 + lh * 256 + l31 * 8;
#pragma unroll
    for (int dt = 0; dt < 4; ++dt) {
      vf[dt * 2] = *(const uint4*)(vp + (dt * 2 + 0) * 512); vf[dt * 2 + 1] = *(const uint4*)(vp + (dt * 2 + 1) * 512);
    }
    __builtin_amdgcn_sched_barrier(0);
    f32x16 s;
#pragma unroll
    for (int r = 0; r < 16; ++r) s[r] = 0.f;
#pragma unroll
    for (int ks = 0; ks < 12; ++ks) s = __builtin_amdgcn_mfma_f32_32x32x16_bf16(kf[ks], *(const bf16x8*)(qs + ks * 16), s, 0, 0, 0);
    float tmax = -1e30f;
#pragma unroll
    for (int r = 0; r < 16; ++r) { s[r] *= ATTN_SCALE; tmax = fmaxf(tmax, s[r]); }
    tmax = fmaxf(tmax, shx32(tmax, lane));
    const float mnew = fmaxf(mrun, tmax);
    const float alpha = expf(mrun - mnew);
    float ps = 0.f;
#pragma unroll
    for (int r = 0; r < 16; ++r) { s[r] = expf(s[r] - mnew); ps += s[r]; }
    ps += shx32(ps, lane);
    lrun = lrun * alpha + ps; mrun = mnew;
#pragma unroll
    for (int dt = 0; dt < 4; ++dt)
#pragma unroll
      for (int r = 0; r < 16; ++r) oacc[dt][r] *= alpha;
#pragma unroll
    for (int sh = 0; sh < 2; ++sh) {
      uint4 pw;
      pw.x = pk2(s[sh * 8 + 0], s[sh * 8 + 1]); pw.y = pk2(s[sh * 8 + 2], s[sh * 8 + 3]);
      pw.z = pk2(s[sh * 8 + 4], s[sh * 8 + 5]); pw.w = pk2(s[sh * 8 + 6], s[sh * 8 + 7]);
      const bf16x8 pf = __builtin_bit_cast(bf16x8, pw);
#pragma unroll
      for (int dt = 0; dt < 4; ++dt)
        oacc[dt] = __builtin_amdgcn_mfma_f32_32x32x16_bf16(__builtin_bit_cast(bf16x8, vf[dt * 2 + sh]), pf, oacc[dt], 0, 0, 0);
    }
  }
  for (int i = tid; i < 8192; i += 256) Oacc[i] = 0.f;
  if (lh == 0) { sm_m[wave * 32 + l31] = mrun; sm_l[wave * 32 + l31] = lrun; }
  __syncthreads();
  {
    const float m0 = sm_m[qt * 32 + l31], m1 = sm_m[(qt + 2) * 32 + l31];
    const float M = fmaxf(m0, m1);
    const float L = sm_l[qt * 32 + l31] * expf(m0 - M) + sm_l[(qt + 2) * 32 + l31] * expf(m1 - M);
    const float f = expf(mrun - M) / L;
    float* oq = Oacc + qt * 4096;
#pragma unroll
    for (int dt = 0; dt < 4; ++dt)
#pragma unroll
      for (int r = 0; r < 16; ++r) {
        const int d = dt * 32 + (r & 3) + 8 * (r >> 2) + 4 * lh;
        atomicAdd(&oq[d * 32 + l31], oacc[dt][r] * f);
      }
  }
  __syncthreads();
  {
    const int q = tid >> 2, dc = (tid & 3) * 32;
    const float* oq = Oacc + (q >> 5) * 4096 + (q & 31);
    bf16_t* dst = OUT + (size_t)(qtok0 + q) * DM + hd * 128 + dc;
#pragma unroll
    for (int h4 = 0; h4 < 4; ++h4) {
      float o[8];
#pragma unroll
      for (int i = 0; i < 8; ++i) o[i] = oq[(dc + h4 * 8 + i) * 32];
      uint4 w; w.x = pk2(o[0], o[1]); w.y = pk2(o[2], o[3]); w.z = pk2(o[4], o[5]); w.w = pk2(o[6], o[7]);
      *(uint4*)(dst + h4 * 8) = w;
    }
  }
  __syncthreads();
}
__device__ __forceinline__ void ph_attn(const C& p) {
  const int tid = p.tid;
  const int half = p.nb >> 1;
  if ((p.vb & 1) == 0) {
    for (int s_ = p.vb >> 1; s_ < 256; s_ += half) {
      const int b = s_ >> 7, hd = (s_ >> 4) & 7;
      attn_item(p, 16 + b, hd, NPR + b * 1024 + (s_ & 15) * 64, tid);
    }
  } else {
    for (int j = p.vb >> 1; j < 256; j += half) {
      for (int u = 0; u < 2; ++u) {
        const int i2 = j * 2 + u;
        const int b = i2 >> 5, hd = (i2 >> 2) & 7;
        attn_item(p, b, hd, b * 256 + (i2 & 3) * 64, tid);
      }
    }
  }
}

__device__ __forceinline__ void ph_final(const C& p) {
  const int tid = p.tid, lane = tid & 63, wave = tid >> 6;
  const float* X = (const float*)(p.ws + WS_XCUR);
  const float* g = p.in[35];
  for (int tok = p.bid * 4 + wave; tok < NTOK; tok += p.nb * 4) {
    const float* x = X + (size_t)tok * DM;
    float4 xv[4]; float ss = 0.f;
#pragma unroll
    for (int i = 0; i < 4; ++i) xv[i] = *(const float4*)(x + (i * 64 + lane) * 4);
    moe_combine_row(p, tok, 1, lane, xv);
#pragma unroll
    for (int i = 0; i < 4; ++i) ss += xv[i].x * xv[i].x + xv[i].y * xv[i].y + xv[i].z * xv[i].z + xv[i].w * xv[i].w;
    ss = wave_sum(ss, lane);
    const float rinv = rsqrtf(ss * (1.f / 1024.f) + RMS_EPS);
#pragma unroll
    for (int i = 0; i < 4; ++i) {
      const int d = (i * 64 + lane) * 4;
      const float4 gv = *(const float4*)(g + d);
      *(float4*)(p.out + O_Y + (size_t)tok * DM + d) = make_float4(xv[i].x * rinv * gv.x, xv[i].y * rinv * gv.y, xv[i].z * rinv * gv.z, xv[i].w * rinv * gv.w);
    }
  }
}

#define NPHASE 24
__device__ __forceinline__ void run_phase(const C& p, int ph) {
  switch (ph) {
    case 0: ph_ada(p); break;
    case 1: case 13: { const int L = ph == 13; ph_prep<false>(p, !L, p.in[9] + L * 1024, L, 0, nullptr); } break;
    case 2: ph_gemm_in0(p); break;
    case 3: ph_mix(p); break;
    case 4: ph_lora(p); break;
    case 5: ph_scan(p); break;
    case 6: ph_scanfix(p); break;
    case 7: ph_post(p); break;
    case 8: case 18: { const int L = ph == 18; ph_gemm_out(p, L ? p.in[30] : p.in[24], L, !L); } break;
    case 9: case 19: { const int L = ph == 19; ph_router(p, p.in[10] + L * 1024, L, p.in[31] + L * 1024 * 16); } break;
    case 10: case 20: ph_topk(p); break;
    case 11: case 21: ph_moe_up(p, ph == 21); break;
    case 12: case 22: ph_moe_down(p, ph == 22); break;
    case 14: ph_gemm_in1(p); break;
    case 15: ph_mla_norm(p); break;
    case 16: ph_mla_qkv(p); break;
    case 17: ph_attn(p); break;
    case 23: ph_final(p); break;
    default: break;
  }
}

__global__ void __launch_bounds__(256, 2) fwd_kernel(P p) {
  if (threadIdx.x == 0) xb_words = make_uint4(0u, 0u, 0u, 0u);
  __syncthreads();
  XcdBarrier bar = xcd_barrier_post((unsigned*)(p.ws + WS_BAR), (volatile LAS unsigned*)&xb_words);
  C c; (P&)c = p; c.nb = gridDim.x;
  const int wv_ = __builtin_amdgcn_readfirstlane(threadIdx.x >> 6);
#ifdef ONLY_PHASE
  c.tid = wv_ * 64 + (int)__builtin_amdgcn_mbcnt_hi(~0u, __builtin_amdgcn_mbcnt_lo(~0u, 0u)); c.bid = blockIdx.x; c.vb = (c.bid & 7) * (c.nb >> 3) + (c.bid >> 3);
  run_phase(c, ONLY_PHASE); xcd_barrier(bar);
#else
  for (int ph = p.ph_lo; ph < p.ph_hi; ++ph) {
    const int reps = (ph == p.probe_ph) ? p.probe_reps : 1;
    for (int r = 0; r < reps; ++r) {
      if (r) __syncthreads();
      int l_; asm volatile("v_mbcnt_lo_u32_b32 %0, -1, 0\n\tv_mbcnt_hi_u32_b32 %0, -1, %0" : "=v"(l_));
      int t_ = wv_ * 64 + l_, b_ = blockIdx.x; unsigned char* w_ = p.ws;
      asm volatile("" : "+v"(t_)); asm volatile("" : "+s"(b_)); asm volatile("" : "+s"(w_));
      c.tid = t_; c.bid = b_; c.ws = w_; c.vb = (b_ & 7) * (c.nb >> 3) + (b_ >> 3);
      run_phase(c, ph);
    }
    if (ph + 1 < p.ph_hi) xcd_barrier(bar);
  }
#endif
}

extern "C" void kernel_launch(void* const* d_in, const int* in_sizes, int n_in, void* d_out, int out_size, void* d_ws, size_t ws_size, hipStream_t stream) {
  static int grid = 0;
  if (grid == 0) {
    int dev = 0, cus = 0, per_cu = 0;
    hipGetDevice(&dev);
    hipDeviceGetAttribute(&cus, hipDeviceAttributeMultiprocessorCount, dev);
    hipOccupancyMaxActiveBlocksPerMultiprocessor(&per_cu, (const void*)fwd_kernel, 256, 0);
    (void)hipGetLastError();
    if (per_cu < 1) per_cu = 1;
    if (per_cu > 2) per_cu = 2;
    grid = cus * per_cu;
    grid &= ~7;
    if (grid < 8) grid = 8;
    if (ws_size < WS_END0) fprintf(stderr, "kernel_launch: workspace too small (%zu < %llu)\n", ws_size, (unsigned long long)WS_END0);
  }
  hipMemsetAsync((char*)d_ws + WS_BAR, 0, XCD_BAR_WORDS * 4, stream);
  P p{};
  for (int i = 0; i < 36; ++i) p.in[i] = (const float*)d_in[i];
  p.out = (float*)d_out; p.ws = (unsigned char*)d_ws;
  p.probe_ph = -1; p.probe_reps = 1;
#ifdef MULTI_LAUNCH
  for (int ph = 0; ph < NPHASE; ++ph) {
    p.ph_lo = ph; p.ph_hi = ph + 1;
    hipLaunchKernelGGL(fwd_kernel, dim3(grid), dim3(256), 0, stream, p);
  }
#else
  p.ph_lo = 0; p.ph_hi = NPHASE;
  hipLaunchKernelGGL(fwd_kernel, dim3(grid), dim3(256), 0, stream, p);
#endif
}
```
